# Optimizing an MI355X kernel written in HIP

```python
import jax, jax.numpy as jnp
from jax import lax
import numpy as np

D_MODEL = 1024
BATCH = 8
SEQ = 4096
DEPTH = 1

HEAD_DIM = 64
RWKV_HEADS = D_MODEL // HEAD_DIM
RWKV_WIDTH = RWKV_HEADS * HEAD_DIM
DECAY_LORA = 64
AAA_LORA = 64
GATE_LORA = 160
RWKV_COLS = 3 * RWKV_WIDTH + DECAY_LORA + AAA_LORA + GATE_LORA
GN_EPS = 64e-5
ATTN_PAIRS = ((128, 1), (512, 4), (2048, 16))
ATTN_GROUPS = 3
ATTN_HEADS_PER_GROUP = 4
ATTN_HEADS = ATTN_GROUPS * ATTN_HEADS_PER_GROUP
ATTN_WIDTH = ATTN_HEADS * HEAD_DIM
N_BRANCHES = 2
IN_COLS = RWKV_COLS + 3 * ATTN_WIDTH + N_BRANCHES * D_MODEL
D_FF = 2816
RMS_EPS = 1e-6
NEG_INF = -1e30

kernel_name = 'hybrid_rwkv7_dilated_attn_macaron'


def _split_last(t, sizes):
    out, start = [], 0
    for n in sizes:
        out.append(t[..., start:start + n])
        start += n
    return out


def rms_norm(x, g):
    xf = x.astype(jnp.float32)
    y = xf * lax.rsqrt(jnp.mean(xf * xf, axis=-1, keepdims=True) + RMS_EPS)
    return y.astype(x.dtype) * g


def swiglu(h, w_in, w_out):
    gate, up = _split_last(h @ w_in, (D_FF, D_FF))
    return (jax.nn.silu(gate) * up) @ w_out


def token_shift(p, mu):
    prev = jnp.pad(p, ((0, 0), (1, 0), (0, 0)))[:, :-1]
    return p + (prev - p) * mu


def wkv7_scan(r, w, k, v, a, b):
    B, S, H, N = r.shape
    to_time = lambda t: jnp.moveaxis(t, 1, 0)

    def step(state, inp):
        r_t, w_t, k_t, v_t, a_t, b_t = inp
        sa = jnp.einsum('bhvk,bhk->bhv', state, a_t)
        state = (state * w_t[:, :, None, :] + sa[..., None] * b_t[:, :, None, :]
                 + v_t[..., None] * k_t[:, :, None, :])
        return state, jnp.einsum('bhvk,bhk->bhv', state, r_t)

    state0 = jnp.zeros((B, H, N, N), jnp.float32)
    _, out = lax.scan(step, state0, (to_time(r), to_time(w), to_time(k),
                                      to_time(v), to_time(a), to_time(b)))
    return jnp.moveaxis(out, 0, 1)


def rwkv7_time_mix(p, mu, w0, w2, a0, a2, g2, k_k, k_a, r_k, ln_w, ln_b):
    B, S, _ = p.shape
    H, N = RWKV_HEADS, HEAD_DIM
    p = token_shift(p.astype(jnp.float32), mu)
    r, k, v, wd, ad, gd = _split_last(
        p, (RWKV_WIDTH, RWKV_WIDTH, RWKV_WIDTH, DECAY_LORA, AAA_LORA, GATE_LORA))
    w = -jax.nn.softplus(-(w0 + jnp.tanh(wd) @ w2)) - 0.5
    decay = jnp.exp(-jnp.exp(w))
    a = jax.nn.sigmoid(a0 + ad @ a2)
    g = jax.nn.sigmoid(gd) @ g2
    heads = lambda t: t.reshape(B, S, H, N)
    kk = heads(k * k_k)
    kk = kk / jnp.maximum(jnp.sqrt(jnp.sum(kk * kk, axis=-1, keepdims=True)), 1e-12)
    k = k * (1.0 + (a - 1.0) * k_a)
    rh, kh, vh, ah = heads(r), heads(k), heads(v), heads(a)
    wkv = wkv7_scan(rh, heads(decay), kh, vh, -kk, kk * ah)
    mean = jnp.mean(wkv, axis=-1, keepdims=True)
    var = jnp.mean(jnp.square(wkv - mean), axis=-1, keepdims=True)
    y = ((wkv - mean) * lax.rsqrt(var + GN_EPS)).reshape(B, S, RWKV_WIDTH) * ln_w + ln_b
    bonus = jnp.sum(rh * kh * r_k, axis=-1, keepdims=True) * vh
    return (y + bonus.reshape(B, S, RWKV_WIDTH)) * g


def dilated_group_attention(q, k, v, window, dilation):
    B, S, Hg, E = q.shape
    span = window // dilation
    blk = span
    sub = S // dilation
    nb = -(-sub // blk)
    pad = nb * blk - sub

    def to_sub(t):
        t = t.reshape(B, sub, dilation, Hg, E).transpose(0, 2, 1, 3, 4)
        t = jnp.pad(t, ((0, 0), (0, 0), (0, pad), (0, 0), (0, 0)))
        return t.reshape(B, dilation, nb, blk, Hg, E)

    def with_prev(t):
        tp = jnp.pad(t, ((0, 0), (0, 0), (1, 0), (0, 0), (0, 0), (0, 0)))
        return jnp.concatenate([tp[:, :, :-1], tp[:, :, 1:]], axis=3)

    qb = to_sub(q)
    kw, vw = with_prev(to_sub(k)), with_prev(to_sub(v))
    s = jnp.einsum('bdnqhe,bdnkhe->bdnhqk', qb, kw)
    qi = jnp.arange(blk)[:, None]
    kj = jnp.arange(2 * blk)[None, :]
    dist = qi + blk - kj
    bidx = jnp.arange(nb)[:, None, None]
    valid = (dist >= 0) & (dist <= span) & (bidx * blk + kj - blk >= 0)
    s = jnp.where(valid[None, None, :, None], s, NEG_INF)
    m = jnp.max(s, axis=-1, keepdims=True)
    pexp = jnp.exp(s - m)
    den = jnp.sum(pexp, axis=-1, keepdims=True)
    o = jnp.einsum('bdnhqk,bdnkhe->bdnqhe', pexp / den, vw)
    lse = (m + jnp.log(den))[..., 0].transpose(0, 1, 2, 4, 3)
    o = o.reshape(B, dilation, nb * blk, Hg, E)[:, :, :sub]
    o = o.transpose(0, 2, 1, 3, 4).reshape(B, S, Hg, E)
    lse = lse.reshape(B, dilation, nb * blk, Hg)[:, :, :sub]
    lse = lse.transpose(0, 2, 1, 3).reshape(B, S, Hg)
    return o, lse


def dilated_attention(pq, pk, pv, q_gain, k_gain):
    B, S, _ = pq.shape
    heads = lambda t: t.astype(jnp.float32).reshape(B, S, ATTN_HEADS, HEAD_DIM)
    q = rms_norm(heads(pq), q_gain) * (HEAD_DIM ** -0.5)
    k = rms_norm(heads(pk), k_gain)
    v = heads(pv)
    outs, lses = [], []
    for gi, (window, dilation) in enumerate(ATTN_PAIRS):
        sl = slice(gi * ATTN_HEADS_PER_GROUP, (gi + 1) * ATTN_HEADS_PER_GROUP)
        o, lse = dilated_group_attention(q[:, :, sl], k[:, :, sl], v[:, :, sl], window, dilation)
        outs.append(o)
        lses.append(lse)
    o = jnp.stack(outs, axis=2)
    alpha = jax.nn.softmax(jnp.stack(lses, axis=2), axis=2)
    return (o * alpha[..., None]).reshape(B, S, ATTN_WIDTH)


def setup_inputs(seed: int = 0) -> dict:
    key = jax.random.key(seed)
    ks = jax.random.split(key, 27)
    f32 = jnp.float32
    L, D = DEPTH, D_MODEL

    def nrm(k, shape, scale):
        return scale * jax.random.normal(k, shape, f32)

    def gain(k, shape):
        return 1.0 + 0.1 * jax.random.normal(k, shape, f32)

    return {
        'x': jax.random.normal(ks[0], (BATCH, SEQ, D), f32),
        'ffn1_norm': gain(ks[1], (L, D)),
        'ffn1_w_in': nrm(ks[2], (L, D, 2 * D_FF), D ** -0.5),
        'ffn1_w_out': nrm(ks[3], (L, D_FF, D), D_FF ** -0.5),
        'mix_norm': gain(ks[4], (L, D)),
        'w_in': nrm(ks[5], (L, D, IN_COLS), D ** -0.5),
        'b_gate': nrm(ks[6], (L, N_BRANCHES * D), 0.1),
        'rwkv_mu': jax.random.uniform(ks[7], (L, RWKV_COLS), f32),
        'rwkv_w0': jax.random.uniform(ks[8], (L, RWKV_WIDTH), f32, -6.0, 0.0),
        'rwkv_w2': nrm(ks[9], (L, DECAY_LORA, RWKV_WIDTH), 0.1 * DECAY_LORA ** -0.5),
        'rwkv_a0': nrm(ks[10], (L, RWKV_WIDTH), 0.1),
        'rwkv_a2': nrm(ks[11], (L, AAA_LORA, RWKV_WIDTH), AAA_LORA ** -0.5),
        'rwkv_g2': nrm(ks[12], (L, GATE_LORA, RWKV_WIDTH), GATE_LORA ** -0.5),
        'rwkv_k_k': gain(ks[13], (L, RWKV_WIDTH)),
        'rwkv_k_a': gain(ks[14], (L, RWKV_WIDTH)),
        'rwkv_r_k': nrm(ks[15], (L, RWKV_HEADS, HEAD_DIM), 0.1),
        'rwkv_ln_w': gain(ks[16], (L, RWKV_WIDTH)),
        'rwkv_ln_b': nrm(ks[17], (L, RWKV_WIDTH), 0.01),
        'attn_q_norm': gain(ks[18], (L, HEAD_DIM)),
        'attn_k_norm': gain(ks[19], (L, HEAD_DIM)),
        'w_proj_rwkv': nrm(ks[20], (L, RWKV_WIDTH, D), RWKV_WIDTH ** -0.5),
        'w_proj_attn': nrm(ks[21], (L, ATTN_WIDTH, D), ATTN_WIDTH ** -0.5),
        'w_out': nrm(ks[22], (L, D, D), D ** -0.5),
        'ffn2_norm': gain(ks[23], (L, D)),
        'ffn2_w_in': nrm(ks[24], (L, D, 2 * D_FF), D ** -0.5),
        'ffn2_w_out': nrm(ks[25], (L, D_FF, D), D_FF ** -0.5),
    }


def reference(x, ffn1_norm, ffn1_w_in, ffn1_w_out, mix_norm, w_in, b_gate, rwkv_mu,
              rwkv_w0, rwkv_w2, rwkv_a0, rwkv_a2, rwkv_g2, rwkv_k_k, rwkv_k_a, rwkv_r_k,
              rwkv_ln_w, rwkv_ln_b, attn_q_norm, attn_k_norm, w_proj_rwkv, w_proj_attn,
              w_out, ffn2_norm, ffn2_w_in, ffn2_w_out):
    for l in range(DEPTH):
        x = x + 0.5 * swiglu(rms_norm(x, ffn1_norm[l]), ffn1_w_in[l], ffn1_w_out[l])
        h = rms_norm(x, mix_norm[l])
        p_rwkv, p_q, p_k, p_v, p_gate = _split_last(
            h @ w_in[l], (RWKV_COLS, ATTN_WIDTH, ATTN_WIDTH, ATTN_WIDTH, N_BRANCHES * D_MODEL))
        y_a = rwkv7_time_mix(p_rwkv, rwkv_mu[l], rwkv_w0[l], rwkv_w2[l], rwkv_a0[l],
                             rwkv_a2[l], rwkv_g2[l], rwkv_k_k[l], rwkv_k_a[l], rwkv_r_k[l],
                             rwkv_ln_w[l], rwkv_ln_b[l]).astype(x.dtype)
        y_b = dilated_attention(p_q, p_k, p_v, attn_q_norm[l], attn_k_norm[l]).astype(x.dtype)
        g_a, g_b = _split_last(jax.nn.sigmoid(p_gate + b_gate[l]), (D_MODEL, D_MODEL))
        merged = g_a * (y_a @ w_proj_rwkv[l]) + g_b * (y_b @ w_proj_attn[l])
        x = x + merged @ w_out[l]
        x = x + 0.5 * swiglu(rms_norm(x, ffn2_norm[l]), ffn2_w_in[l], ffn2_w_out[l])
    return x
```

```cpp
#include <hip/hip_runtime.h>
#include <cstdio>
#include <cstdint>
constexpr int NWAVES = 8;
constexpr int NB_ = 8, SEQ = 4096, D = 1024, FF = 2816, M = NB_ * SEQ;
constexpr int RW_COLS = 3360, IN_COLS = 7712, AW = 768, NHA = 12;
constexpr int NPH = 11;
#ifndef MK_N_LAUNCHES
#define MK_N_LAUNCHES 1
#endif
constexpr int N_LAUNCHES = MK_N_LAUNCHES;

constexpr size_t MiB = 1u << 20;
constexpr size_t WS_CTL = 0, CTL_ZERO_BYTES = 1 * MiB;
constexpr size_t WS_W1T = 1 * MiB;
constexpr size_t WS_W2T = 12 * MiB;
constexpr size_t WS_WIN = 17 * MiB + 512 * 1024;
constexpr size_t WS_WG  = 29 * MiB;
constexpr size_t WS_WA  = 33 * MiB;
constexpr size_t WS_WB  = 35 * MiB;
constexpr size_t WS_WO  = 36 * MiB + 512 * 1024;
constexpr size_t WS_G2T = 38 * MiB + 512 * 1024;
constexpr size_t WS_W3T = 39 * MiB;
constexpr size_t WS_W4T = 50 * MiB;
constexpr size_t WS_L2T = 55 * MiB + 512 * 1024;
constexpr size_t WS_SS0 = 56 * MiB, WS_SS1 = 58 * MiB, WS_SS2 = 60 * MiB;
constexpr size_t WS_LSE = 62 * MiB;
constexpr size_t WS_BON = 64 * MiB;
constexpr size_t WS_ACT = 66 * MiB;
constexpr size_t WS_PR = 66 * MiB, WS_PK = 130 * MiB, WS_PV = 194 * MiB;
constexpr size_t WS_GATES = 66 * MiB;
constexpr size_t WS_LORA = 258 * MiB;
constexpr size_t WS_AQ = 276 * MiB, WS_AK = 324 * MiB, WS_AV = 372 * MiB;
constexpr size_t WS_WKV = 324 * MiB;
constexpr size_t WS_SGD = 388 * MiB;
constexpr size_t WS_XB1 = 420 * MiB;
constexpr size_t WS_MRG = 420 * MiB;
constexpr size_t WS_XB2 = 276 * MiB;
constexpr size_t WS_END = 484 * MiB;
constexpr int CW_BAR = 4096;

constexpr int RING_OFF = 0, RING_BYTES = 131072;
constexpr int LDSCTL_OFF = RING_BYTES, MISC_OFF = LDSCTL_OFF + 320;
constexpr int LDS_BYTES = 147456;

namespace pg8 {
#define PG8_LAS __attribute__((address_space(3)))
typedef unsigned short bf16_t;
typedef short bf16x8 __attribute__((ext_vector_type(8)));
typedef float f32x4 __attribute__((ext_vector_type(4)));
typedef unsigned u32x4 __attribute__((ext_vector_type(4)));
constexpr int BM = 256, BK = 64, HALF = 128, HTB = HALF * BK * 2  , STAGE_BYTES = 8 * HTB, NXCD = 8, WGM = 8;

__host__ __device__ __forceinline__ int lds_byte(int r, int c) { const int st = (r >> 4) * 2 + (c >> 5), rr = r & 15, cc = c & 31, ob = rr * 64 + cc * 2; return st * 1024 + (ob ^ (((ob >> 9) & 1) << 5)); }
__host__ __device__ __forceinline__ void stage_rc(int b, int& R, int& C) { const int st = b / 1024, sb = b % 1024, swz = sb ^ (((sb >> 9) & 1) << 5); R = (st >> 1) * 16 + swz / 64; C = (st & 1) * 32 + (swz % 64) / 2; }
__host__ __device__ __forceinline__ int perm32(int rho) { const int n = rho >> 4, i = rho & 15; return 8 * (i >> 2) + 4 * n + (i & 3); }

struct Unit { int pm, pn; };
struct Gemm { const bf16_t* A; const bf16_t* Bt; int M, N, K; };

struct StaticOrder {
    int nM, nN, nwg, G, c;
    __host__ __device__ void init(int M, int N, int G_, int c_) { nM = M / BM; nN = N / BM; nwg = nM * nN; G = G_; c = c_; }
    __host__ __device__ bool next(int i, Unit& u) const {
        const long L = (long)i * G + c; if (L >= nwg) return false;
        int wgid = (int)L; { const int q = nwg / NXCD, r = nwg % NXCD, xcd = wgid % NXCD, off = wgid / NXCD; wgid = (xcd < r ? xcd * (q + 1) : r * (q + 1) + (xcd - r) * q) + off; }
        const int nig = WGM * nN, gid = wgid / nig, fm = gid * WGM, gsz = (nM - fm) < WGM ? (nM - fm) : WGM;
        u.pm = fm + ((wgid % nig) % gsz); u.pn = (wgid % nig) / gsz; return true;
    }
    __device__ __forceinline__ void a_ready(const Unit&) const {}
    __device__ __forceinline__ void done(const Unit&) const {}
};

typedef float f32x2c_t __attribute__((ext_vector_type(2))); typedef __bf16 bf16x2c_t __attribute__((ext_vector_type(2)));
__device__ __forceinline__ unsigned cvt_pk_bf16(float lo, float hi) { f32x2c_t v = {lo, hi}; bf16x2c_t b = __builtin_convertvector(v, bf16x2c_t); return __builtin_bit_cast(unsigned, b); }
typedef float f32x2 __attribute__((ext_vector_type(2)));
__device__ __forceinline__ float fast_sigmoid(float x) { return __builtin_amdgcn_rcpf(1.0f + __expf(-x)); }
__device__ __forceinline__ float row_scale_from_ss(const float* ss, int row) {
    const f32x4* p = (const f32x4*)(ss + (size_t)row * 16);
    const f32x4 a = p[0], b = p[1], c = p[2], d = p[3];
    const float s = ((a[0] + a[1]) + (a[2] + a[3])) + ((b[0] + b[1]) + (b[2] + b[3])) + ((c[0] + c[1]) + (c[2] + c[3])) + ((d[0] + d[1]) + (d[2] + d[3]));
    return __builtin_amdgcn_rsqf(s * (1.0f / 1024.0f) + 1e-6f);
}
__device__ __forceinline__ u32x4 pack8(const f32x4 a, const f32x4 b) { u32x4 w; w.x = cvt_pk_bf16(a[0], a[1]); w.y = cvt_pk_bf16(a[2], a[3]); w.z = cvt_pk_bf16(b[0], b[1]); w.w = cvt_pk_bf16(b[2], b[3]); return w; }
__device__ __forceinline__ void unpack8(const u32x4 w, f32x4& a, f32x4& b) {
    a[0] = __uint_as_float(w.x << 16); a[1] = __uint_as_float(w.x & 0xffff0000u); a[2] = __uint_as_float(w.y << 16); a[3] = __uint_as_float(w.y & 0xffff0000u);
    b[0] = __uint_as_float(w.z << 16); b[1] = __uint_as_float(w.z & 0xffff0000u); b[2] = __uint_as_float(w.w << 16); b[3] = __uint_as_float(w.w & 0xffff0000u);
}
constexpr int FFN_HID = 2816;

struct EpiSwiglu {
    static constexpr bool PERM = true, AFTER_DRAIN = false;
    bf16_t* O; const float* ss;
    __device__ __forceinline__ void operator()(const f32x4 (&acc)[2][2][4][2], const Unit& u, int wr, int wc, int fr, int fq) const {
        const int row0 = u.pm * BM + wr * 64 + fr, col0 = u.pn * 128 + wc * 32 + 8 * fq;
#pragma unroll
        for (int ai = 0; ai < 2; ++ai)
#pragma unroll
            for (int m = 0; m < 4; ++m) {
                const int row = row0 + ai * HALF + m * 16; const float s = row_scale_from_ss(ss, row);
                f32x4 o[2];
#pragma unroll
                for (int n = 0; n < 2; ++n)
#pragma unroll
                    for (int i = 0; i < 4; ++i) { const float g = acc[ai][0][m][n][i] * s, up = acc[ai][1][m][n][i] * s; o[n][i] = g * fast_sigmoid(g) * up; }
                *(u32x4*)(O + (size_t)row * FFN_HID + col0) = pack8(o[0], o[1]);
            }
    }
};

template <bool WITH_BF16> struct EpiResid {
    static constexpr bool PERM = true, AFTER_DRAIN = false;
    const float* base; float* out; bf16_t* xb; float* ss; float scale;
    __device__ __forceinline__ void operator()(const f32x4 (&acc)[2][2][4][2], const Unit& u, int wr, int wc, int fr, int fq) const {
        const int row0 = u.pm * BM + wr * 64 + fr, col0 = u.pn * BM + wc * 32 + 8 * fq;
#pragma unroll
        for (int ai = 0; ai < 2; ++ai)
#pragma unroll
            for (int m = 0; m < 4; ++m) {
                const int row = row0 + ai * HALF + m * 16; const size_t off = (size_t)row * 1024 + col0; float q = 0.f;
#pragma unroll
                for (int bj = 0; bj < 2; ++bj) {
                    const f32x4 b0 = *(const f32x4*)(base + off + bj * HALF), b1 = *(const f32x4*)(base + off + bj * HALF + 4);
                    const f32x4 o0 = b0 + acc[ai][bj][m][0] * scale, o1 = b1 + acc[ai][bj][m][1] * scale;
                    *(f32x4*)(out + off + bj * HALF) = o0; *(f32x4*)(out + off + bj * HALF + 4) = o1;
                    if (WITH_BF16) {
                        *(u32x4*)(xb + off + bj * HALF) = pack8(o0, o1);
                        q += (o0[0] * o0[0] + o0[1] * o0[1]) + (o0[2] * o0[2] + o0[3] * o0[3]) + (o1[0] * o1[0] + o1[1] * o1[1]) + (o1[2] * o1[2] + o1[3] * o1[3]);
                    }
                }
                if (WITH_BF16) { q += __shfl_xor(q, 16); q += __shfl_xor(q, 32); if (fq == 0) ss[(size_t)row * 16 + u.pn * 4 + wc] = q; }
            }
    }
};

struct EpiMix {
    static constexpr bool PERM = true, AFTER_DRAIN = false;
    unsigned char* ws; const float* ss; const float* qgain; const float* kgain;
    __device__ __forceinline__ void operator()(const f32x4 (&acc)[2][2][4][2], const Unit& u, int wr, int wc, int fr, int fq) const {
        const int row0 = u.pm * BM + wr * 64 + fr; const int pn = u.pn;
        if (pn >= 14 && pn < 20) {
            const int isk = pn >= 17 ? 1 : 0; const int head = 4 * (pn - 14 - 3 * isk) + wc;
            bf16_t* dst = (bf16_t*)(ws + WS_AQ + (size_t)isk * (WS_AK - WS_AQ)); const float* gain = qgain + (kgain - qgain) * isk;
            const float post = isk ? 1.0f : 0.125f * 1.4426950408889634f;
            f32x4 gv[2][2];
#pragma unroll
            for (int bj = 0; bj < 2; ++bj)
#pragma unroll
                for (int n = 0; n < 2; ++n) gv[bj][n] = *(const f32x4*)(gain + bj * 32 + 8 * fq + 4 * n) * post;
#pragma unroll
            for (int ai = 0; ai < 2; ++ai)
#pragma unroll
                for (int m = 0; m < 4; ++m) {
                    const int row = row0 + ai * HALF + m * 16; const float s = row_scale_from_ss(ss, row); float q = 0.f; f32x4 v[2][2];
#pragma unroll
                    for (int bj = 0; bj < 2; ++bj)
#pragma unroll
                        for (int n = 0; n < 2; ++n) { v[bj][n] = acc[ai][bj][m][n] * s; const f32x4 x = v[bj][n]; q += (x[0] * x[0] + x[1] * x[1]) + (x[2] * x[2] + x[3] * x[3]); }
                    q += __shfl_xor(q, 16); q += __shfl_xor(q, 32);
                    const float rn = __builtin_amdgcn_rsqf(q * (1.0f / 64.0f) + 1e-6f);
#pragma unroll
                    for (int bj = 0; bj < 2; ++bj) *(u32x4*)(dst + (size_t)row * 768 + head * 64 + bj * 32 + 8 * fq) = pack8(v[bj][0] * rn * gv[bj][0], v[bj][1] * rn * gv[bj][1]);
                }
            return;
        }
        size_t boff; int ld, colt, lim;
        if (pn < 12) { boff = WS_PR + (size_t)(pn >> 2) * (WS_PK - WS_PR); ld = 1024; colt = (pn & 3) * 256; lim = 1 << 30; }
        else if (pn < 14) { boff = WS_LORA; ld = 288; colt = (pn - 12) * 256; lim = 288; }
        else { boff = WS_AV; ld = 768; colt = (pn - 20) * 256; lim = 1 << 30; }
        bf16_t* dst = (bf16_t*)(ws + boff);
        const int col0 = colt + wc * 32 + 8 * fq;
#pragma unroll
        for (int ai = 0; ai < 2; ++ai)
#pragma unroll
            for (int m = 0; m < 4; ++m) {
                const int row = row0 + ai * HALF + m * 16; const float s = row_scale_from_ss(ss, row);
#pragma unroll
                for (int bj = 0; bj < 2; ++bj) { const int c = col0 + bj * HALF; if (c < lim) *(u32x4*)(dst + (size_t)row * ld + c) = pack8(acc[ai][bj][m][0] * s, acc[ai][bj][m][1] * s); }
            }
    }
};

struct EpiGates {
    static constexpr bool PERM = true, AFTER_DRAIN = false;
    bf16_t* G; const float* ss; const float* bgate;
    __device__ __forceinline__ void operator()(const f32x4 (&acc)[2][2][4][2], const Unit& u, int wr, int wc, int fr, int fq) const {
        const int row0 = u.pm * BM + wr * 64 + fr, col0 = u.pn * BM + wc * 32 + 8 * fq;
        f32x4 bv[2][2];
#pragma unroll
        for (int bj = 0; bj < 2; ++bj)
#pragma unroll
            for (int n = 0; n < 2; ++n) bv[bj][n] = *(const f32x4*)(bgate + col0 + bj * HALF + 4 * n);
#pragma unroll
        for (int ai = 0; ai < 2; ++ai)
#pragma unroll
            for (int m = 0; m < 4; ++m) {
                const int row = row0 + ai * HALF + m * 16; const float s = row_scale_from_ss(ss, row);
#pragma unroll
                for (int bj = 0; bj < 2; ++bj) { f32x4 o[2];
#pragma unroll
                    for (int n = 0; n < 2; ++n)
#pragma unroll
                        for (int i = 0; i < 4; ++i) o[n][i] =
#if defined(T1_PLAIN)
 acc[ai][bj][m][n][i];
#elif defined(T6_CONST)
 0.5f;
#elif defined(T4_SIG)
 fast_sigmoid(acc[ai][bj][m][n][i]);
#elif defined(T5_MUL)
 acc[ai][bj][m][n][i] * s;
#elif defined(T2_S)
 fast_sigmoid(acc[ai][bj][m][n][i] * s);
#elif defined(T3_B)
 fast_sigmoid(acc[ai][bj][m][n][i] + bv[bj][n][i]);
#else
 fast_sigmoid(acc[ai][bj][m][n][i] * s + bv[bj][n][i]);
#endif
                    *(u32x4*)(G + (size_t)row * 2048 + col0 + bj * HALF) = pack8(o[0], o[1]); }
            }
    }
};

struct EpiGn {
    static constexpr bool PERM = true, AFTER_DRAIN = false;
    bf16_t* wkv; const bf16_t* pv; const float* bonus; const float* muv; const float* lnw; const float* lnb;
    __device__ __forceinline__ void operator()(const f32x4 (&acc)[2][2][4][2], const Unit& u, int wr, int wc, int fr, int fq) const {
        const int row0 = u.pm * BM + wr * 64 + fr; const int head = 4 * u.pn + wc; const int cb = head * 64 + 8 * fq;
#pragma unroll
        for (int ai = 0; ai < 2; ++ai)
#pragma unroll
            for (int m = 0; m < 4; ++m) {
                int row = row0 + ai * HALF + m * 16; asm volatile("" : "+v"(row) :: "memory"); const bool hasprev = (row & 4095) != 0;
                f32x4 x[2][2]; float s1 = 0.f;
#pragma unroll
                for (int bj = 0; bj < 2; ++bj) {
                    unpack8(*(const u32x4*)(wkv + (size_t)row * 1024 + cb + bj * 32), x[bj][0], x[bj][1]);
#pragma unroll
                    for (int n = 0; n < 2; ++n) s1 += (x[bj][n][0] + x[bj][n][1]) + (x[bj][n][2] + x[bj][n][3]);
                }
                s1 += __shfl_xor(s1, 16); s1 += __shfl_xor(s1, 32);
                const float mean = s1 * (1.0f / 64.0f); float s2 = 0.f;
#pragma unroll
                for (int bj = 0; bj < 2; ++bj)
#pragma unroll
                    for (int n = 0; n < 2; ++n) { x[bj][n] = x[bj][n] - mean; const f32x4 d = x[bj][n]; s2 += (d[0] * d[0] + d[1] * d[1]) + (d[2] * d[2] + d[3] * d[3]); }
                s2 += __shfl_xor(s2, 16); s2 += __shfl_xor(s2, 32);
                const float rstd = __builtin_amdgcn_rsqf(s2 * (1.0f / 64.0f) + 64e-5f);
                const float bon = bonus[(size_t)row * 16 + head];
#pragma unroll
                for (int bj = 0; bj < 2; ++bj) {
                    const size_t off = (size_t)row * 1024 + cb + bj * 32;
                    f32x4 vc[2], vp[2]; unpack8(*(const u32x4*)(pv + off), vc[0], vc[1]);
                    if (hasprev) unpack8(*(const u32x4*)(pv + off - 1024), vp[0], vp[1]); else { vp[0] = (f32x4){0.f, 0.f, 0.f, 0.f}; vp[1] = vp[0]; }
                    f32x4 o[2];
#pragma unroll
                    for (int n = 0; n < 2; ++n) { const int c = cb + bj * 32 + 4 * n;
                        const f32x4 w_ = *(const f32x4*)(lnw + c), b_ = *(const f32x4*)(lnb + c), mu_ = *(const f32x4*)(muv + c);
                        const f32x4 vs = vc[n] + (vp[n] - vc[n]) * mu_;
                        o[n] = (x[bj][n] * rstd * w_ + b_ + vs * bon) * acc[ai][bj][m][n]; }
                    *(u32x4*)(wkv + off) = pack8(o[0], o[1]);
                    asm volatile("" ::: "memory"); }
            }
    }
};

template <bool SECOND> struct EpiProj {
    static constexpr bool PERM = true, AFTER_DRAIN = false;
    bf16_t* mg; const bf16_t* gates;
    __device__ __forceinline__ void operator()(const f32x4 (&acc)[2][2][4][2], const Unit& u, int wr, int wc, int fr, int fq) const {
        const int row0 = u.pm * BM + wr * 64 + fr, col0 = u.pn * BM + wc * 32 + 8 * fq;
#pragma unroll
        for (int ai = 0; ai < 2; ++ai)
#pragma unroll
            for (int m = 0; m < 4; ++m) {
                const int row = row0 + ai * HALF + m * 16;
#pragma unroll
                for (int bj = 0; bj < 2; ++bj) {
                    f32x4 g0, g1; unpack8(*(const u32x4*)(gates + (size_t)row * 2048 + (SECOND ? 1024 : 0) + col0 + bj * HALF), g0, g1);
                    f32x4 o0 = g0 * acc[ai][bj][m][0], o1 = g1 * acc[ai][bj][m][1];
                    bf16_t* p = mg + (size_t)row * 1024 + col0 + bj * HALF;
                    if (SECOND) { f32x4 t0, t1; unpack8(*(const u32x4*)p, t0, t1); o0 += t0; o1 += t1; }
                    *(u32x4*)p = pack8(o0, o1);
                }
            }
    }
};
template <class Epi, class Sched, bool ALIGN_EPI = false, bool SP2 = false>
__device__ __forceinline__ void gemm_phase(PG8_LAS unsigned char* lds, const Gemm g, const Sched& S, const Epi& E) {
    int tid_ = threadIdx.x; asm volatile("" : "+v"(tid_));
    const int tid = tid_, wid = __builtin_amdgcn_readfirstlane(tid >> 6), lane = tid & 63, wr = wid >> 2, wc = wid & 3, fr = lane & 15, fq = lane >> 4;
    const int K = g.K, nt = K / BK;
    unsigned voffA[2], voffB[2];
#pragma unroll
    for (int i = 0; i < 2; ++i) { int R, C; stage_rc(tid * 16 + i * 8192, R, C); const int Rb = Epi::PERM ? ((R & ~31) + perm32(R & 31)) : R;
        voffA[i] = (unsigned)(R * K + C) * 2u; voffB[i] = (unsigned)(Rb * K + C) * 2u; }
    const size_t kstep = (size_t)(BK * 2);
    const size_t hstep = (size_t)HALF * K * 2;
    const size_t tstep = 2 * hstep;
    const unsigned ldsw = (unsigned)wid * 1024u;
    const int aoff = lds_byte(wr * 64 + fr, fq * 8), boff = lds_byte(wc * 32 + fr, fq * 8);
#define PG8_SA(b, h) (((b) * 2 + (h)) * HTB)
#define PG8_SB(b, h) ((4 + (b) * 2 + (h)) * HTB)
#define PG8_STAGE(bufoff, gbase, voff) do { _Pragma("unroll") for (int _i = 0; _i < 2; ++_i) \
        __builtin_amdgcn_global_load_lds((const unsigned*)((const char*)(gbase) + (voff)[_i]), (PG8_LAS unsigned*)(lds + (bufoff) + ldsw + _i * 8192), 16, 0, 0); } while (0)
#define PG8_LDA(dst, b, h) do { _Pragma("unroll") for (int m = 0; m < 4; ++m) _Pragma("unroll") for (int k = 0; k < 2; ++k) dst[m][k] = *(const PG8_LAS bf16x8*)(lds + PG8_SA(b, h) + aoff + m * 2048 + k * 1024); } while (0)
#define PG8_LDB(dst, b, h) do { _Pragma("unroll") for (int n = 0; n < 2; ++n) _Pragma("unroll") for (int k = 0; k < 2; ++k) dst[n][k] = *(const PG8_LAS bf16x8*)(lds + PG8_SB(b, h) + boff + n * 2048 + k * 1024); } while (0)
#define PG8_MMA(ai, bj, At, Bt) do { __builtin_amdgcn_s_setprio(1); _Pragma("unroll") for (int m = 0; m < 4; ++m) _Pragma("unroll") for (int n = 0; n < 2; ++n) _Pragma("unroll") for (int k = 0; k < 2; ++k) \
        acc[ai][bj][m][n] = __builtin_amdgcn_mfma_f32_16x16x32_bf16(Bt[n][k], At[m][k], acc[ai][bj][m][n], 0, 0, 0); __builtin_amdgcn_s_setprio(0); } while (0)
#define PG8_WAIT_V(n) asm volatile("s_waitcnt vmcnt(" #n ")" ::: "memory")
#define PG8_WAIT_L(n) asm volatile("s_waitcnt lgkmcnt(" #n ")" ::: "memory")
#define PG8_BAR __builtin_amdgcn_s_barrier()
#define PG8_SCHED __builtin_amdgcn_sched_barrier(0)
    Unit cur, nxt; int ui = 0;
    if (!S.next(0, cur)) return;
    f32x4 acc[2][2][4][2];
#pragma unroll
    for (int a = 0; a < 2; ++a)
#pragma unroll
        for (int b = 0; b < 2; ++b)
#pragma unroll
            for (int m = 0; m < 4; ++m)
#pragma unroll
                for (int n = 0; n < 2; ++n) acc[a][b][m][n] = (f32x4){0.f, 0.f, 0.f, 0.f};
    bf16x8 At[4][2], B0[2][2], B1[2][2];
    const char* cA = (const char*)g.A + (size_t)cur.pm * tstep; const char* cB = (const char*)g.Bt + (size_t)cur.pn * tstep;
    S.a_ready(cur);
    if constexpr (SP2) {
        PG8_STAGE(PG8_SB(0, 0), cB, voffB); PG8_STAGE(PG8_SB(0, 1), cB + hstep, voffB); PG8_STAGE(PG8_SA(0, 0), cA, voffA); PG8_STAGE(PG8_SA(0, 1), cA + hstep, voffA);
        if (wr == 1) PG8_BAR;
        PG8_WAIT_V(2); PG8_BAR;
        PG8_STAGE(PG8_SB(1, 0), cB + kstep, voffB); PG8_STAGE(PG8_SA(1, 0), cA + kstep, voffA); PG8_STAGE(PG8_SB(1, 1), cB + hstep + kstep, voffB);
        PG8_WAIT_V(6); PG8_BAR;
    } else {
        PG8_STAGE(PG8_SB(0, 0), cB, voffB); PG8_STAGE(PG8_SA(0, 0), cA, voffA); PG8_STAGE(PG8_SB(0, 1), cB + hstep, voffB); PG8_STAGE(PG8_SA(0, 1), cA + hstep, voffA);
        if (wr == 1) PG8_BAR;
        PG8_WAIT_V(4); PG8_BAR;
        PG8_STAGE(PG8_SB(1, 0), cB + kstep, voffB); PG8_STAGE(PG8_SA(1, 0), cA + kstep, voffA); PG8_STAGE(PG8_SB(1, 1), cB + hstep + kstep, voffB);
        PG8_WAIT_V(6); PG8_BAR;
    }
    for (;;) {
        const bool has_next = S.next(ui + 1, nxt);
        const char* nA = has_next ? (const char*)g.A + (size_t)nxt.pm * tstep : cA; const char* nB = has_next ? (const char*)g.Bt + (size_t)nxt.pn * tstep : cB;
        for (int t = 0; t < nt; t += 2) {
            const bool last = (t == nt - 2);
            const char* a1 = cA + (size_t)(t + 1) * kstep;
            const char* a2 = last ? nA : cA + (size_t)(t + 2) * kstep; const char* b2 = last ? nB : cB + (size_t)(t + 2) * kstep;
            const char* a3 = a2 + kstep; const char* b3 = b2 + kstep;
            if (last && has_next) S.a_ready(nxt);
            if constexpr (SP2) {
            PG8_LDB(B0, 0, 0); PG8_LDB(B1, 0, 1); PG8_SCHED; PG8_LDA(At, 0, 0); PG8_STAGE(PG8_SA(1, 1), a1 + hstep, voffA);
            PG8_WAIT_V(8); PG8_WAIT_L(0); PG8_BAR; PG8_MMA(0, 0, At, B0); PG8_MMA(0, 1, At, B1); PG8_BAR; PG8_SCHED;
            PG8_LDA(At, 0, 1); PG8_STAGE(PG8_SB(0, 0), b2, voffB); PG8_STAGE(PG8_SB(0, 1), b2 + hstep, voffB); PG8_STAGE(PG8_SA(0, 0), a2, voffA);
            PG8_WAIT_V(8); PG8_WAIT_L(0); PG8_BAR; PG8_MMA(1, 0, At, B0); PG8_MMA(1, 1, At, B1); PG8_BAR; PG8_SCHED;
            PG8_LDB(B0, 1, 0); PG8_LDB(B1, 1, 1); PG8_SCHED; PG8_LDA(At, 1, 0); PG8_STAGE(PG8_SA(0, 1), a2 + hstep, voffA);
            PG8_WAIT_V(8); PG8_WAIT_L(0); PG8_BAR; PG8_MMA(0, 0, At, B0); PG8_MMA(0, 1, At, B1); PG8_BAR; PG8_SCHED;
            PG8_LDA(At, 1, 1); PG8_STAGE(PG8_SB(1, 0), b3, voffB); PG8_STAGE(PG8_SB(1, 1), b3 + hstep, voffB); PG8_STAGE(PG8_SA(1, 0), a3, voffA);
            PG8_WAIT_V(8); PG8_WAIT_L(0); PG8_BAR; PG8_MMA(1, 0, At, B0); PG8_MMA(1, 1, At, B1); PG8_BAR; PG8_SCHED;
            } else {
            PG8_LDB(B0, 0, 0); PG8_SCHED; PG8_LDA(At, 0, 0); PG8_STAGE(PG8_SA(1, 1), a1 + hstep, voffA);
            PG8_WAIT_L(8); PG8_BAR; PG8_WAIT_L(0); PG8_MMA(0, 0, At, B0); PG8_BAR; PG8_SCHED;
            PG8_LDB(B1, 0, 1); PG8_STAGE(PG8_SB(0, 0), b2, voffB);
            PG8_BAR; PG8_WAIT_L(0); PG8_MMA(0, 1, At, B1); PG8_BAR;
            PG8_LDA(At, 0, 1); PG8_STAGE(PG8_SA(0, 0), a2, voffA);
            PG8_BAR; PG8_WAIT_L(0); PG8_MMA(1, 0, At, B0); PG8_BAR; PG8_SCHED;
            PG8_STAGE(PG8_SB(0, 1), b2 + hstep, voffB);
            PG8_WAIT_V(6); PG8_BAR; PG8_MMA(1, 1, At, B1); PG8_BAR;
            PG8_LDB(B0, 1, 0); PG8_SCHED; PG8_LDA(At, 1, 0); PG8_STAGE(PG8_SA(0, 1), a2 + hstep, voffA);
            PG8_WAIT_L(8); PG8_BAR; PG8_WAIT_L(0); PG8_MMA(0, 0, At, B0); PG8_BAR; PG8_SCHED;
            PG8_LDB(B1, 1, 1); PG8_STAGE(PG8_SB(1, 0), b3, voffB);
            PG8_BAR; PG8_WAIT_L(0); PG8_MMA(0, 1, At, B1); PG8_BAR;
            PG8_LDA(At, 1, 1); PG8_STAGE(PG8_SA(1, 0), a3, voffA);
            PG8_BAR; PG8_WAIT_L(0); PG8_MMA(1, 0, At, B0); PG8_BAR; PG8_SCHED;
            PG8_STAGE(PG8_SB(1, 1), b3 + hstep, voffB);
            PG8_WAIT_V(6); PG8_BAR; PG8_MMA(1, 1, At, B1); PG8_BAR;
            }
        }
        if constexpr (ALIGN_EPI) { if (wr == 0) PG8_BAR; }
        if constexpr (!Epi::AFTER_DRAIN) { E(acc, cur, wr, wc, fr, fq); S.done(cur); }
        if (!has_next) break;
#pragma unroll
        for (int a = 0; a < 2; ++a)
#pragma unroll
            for (int b = 0; b < 2; ++b)
#pragma unroll
                for (int m = 0; m < 4; ++m)
#pragma unroll
                    for (int n = 0; n < 2; ++n) acc[a][b][m][n] = (f32x4){0.f, 0.f, 0.f, 0.f};
        cur = nxt; cA = nA; cB = nB; ++ui;
        if constexpr (ALIGN_EPI) { if (wr == 1) PG8_BAR; }
    }
    PG8_WAIT_V(0);
    if constexpr (!ALIGN_EPI) { if (wr == 0) PG8_BAR; }
    PG8_BAR;
    if constexpr (Epi::AFTER_DRAIN) { E.fused(acc, cur, wr, wc, fr, fq, lds, wid, lane); S.done(cur); }
#undef PG8_SA
#undef PG8_SB
#undef PG8_STAGE
#undef PG8_LDA
#undef PG8_LDB
#undef PG8_MMA
#undef PG8_WAIT_V
#undef PG8_WAIT_L
#undef PG8_BAR
#undef PG8_SCHED
}
}
#define GAS __attribute__((address_space(1)))
#define LAS __attribute__((address_space(3)))
typedef unsigned short bf16;
typedef unsigned v4u __attribute__((ext_vector_type(4)));
typedef float f32x4 __attribute__((ext_vector_type(4)));
typedef short bf16x8 __attribute__((ext_vector_type(8)));
typedef GAS unsigned gu32;
typedef GAS unsigned long long gu64;
#define RLX_AGENT __ATOMIC_RELAXED, __HIP_MEMORY_SCOPE_AGENT
#define LDS_WAIT() asm volatile("s_waitcnt lgkmcnt(0)" ::: "memory")
#define VM_WAIT() asm volatile("s_waitcnt vmcnt(0)" ::: "memory")
__device__ __forceinline__ unsigned long long rt() { return __builtin_amdgcn_s_memrealtime(); }
__device__ __forceinline__ unsigned f2bf(float f) { unsigned u = __builtin_bit_cast(unsigned, f); return (u + 0x7fffu + ((u >> 16) & 1u)) >> 16; }
__device__ __forceinline__ unsigned pk2(float lo, float hi) { return f2bf(lo) | (f2bf(hi) << 16); }
#define XB_TMO      128
#define XB_XCNT(j)  (256  + 64 * (j))
#define XB_XSUB(j)  (1280 + 64 * (j))
#define XB_XGEN(j)  (2304 + 64 * (j))
#define XB_TOP      3328
#define XB_TOPGEN   3392
#define XCD_BAR_WORDS 3456
#define XB_SPIN_CAP (1u << 18)

__device__ __forceinline__ unsigned xb_ld(unsigned* p)              { return __hip_atomic_load(p, __ATOMIC_RELAXED, __HIP_MEMORY_SCOPE_AGENT); }
__device__ __forceinline__ unsigned xb_add(unsigned* p, unsigned v) { return __hip_atomic_fetch_add(p, v, __ATOMIC_RELAXED, __HIP_MEMORY_SCOPE_AGENT); }
__device__ __forceinline__ unsigned xb_xcc_id() { return (unsigned)__builtin_amdgcn_s_getreg((3 << 11) | 20) & 0xFu; }
#define XB_SPIN(cond, bar) do { unsigned _sp = 0; while (cond) { __builtin_amdgcn_s_sleep(1); \
    if ((++_sp & 255u) == 0u) { if (xb_ld(&(bar)[XB_TMO])) break; if (_sp > XB_SPIN_CAP) { atomicAdd(&(bar)[XB_TMO], 1u); break; } } } } while (0)

struct XcdBarrier {
    unsigned* bar; unsigned x;
    volatile LAS unsigned* st;
};

__device__ __forceinline__ XcdBarrier xcd_barrier_post(unsigned* bar, volatile LAS unsigned* st) {
    XcdBarrier b; b.bar = bar; b.x = xb_xcc_id(); b.st = st;
    if (threadIdx.x == 0) (void)xb_add(&bar[XB_XCNT(b.x)], 1u);
    return b;
}
__device__ __forceinline__ void xcd_barrier_complete(unsigned* bar, unsigned x, unsigned& nloc, unsigned& nx) {
    const unsigned G = gridDim.x * gridDim.y * gridDim.z;
    unsigned sum, cnt, mine, sp = 0u;
    for (;;) {
        sum = 0u; cnt = 0u; mine = 0u;
#pragma unroll
        for (unsigned j = 0; j < 16; ++j) { const unsigned c = xb_ld(&bar[XB_XCNT(j)]); sum += c; cnt += (c > 0u) ? 1u : 0u; mine = (j == x) ? c : mine; }
        if (sum == G) break;
        __builtin_amdgcn_s_sleep(1);
        if ((++sp & 255u) == 0u) { if (xb_ld(&bar[XB_TMO])) break; if (sp > XB_SPIN_CAP) { atomicAdd(&bar[XB_TMO], 1u); break; } }
    }
    nloc = mine > 0u ? mine : 1u; nx = cnt > 0u ? cnt : 1u;
}

__device__ __forceinline__ void xcd_barrier(const XcdBarrier& b) {
    asm volatile("s_waitcnt vmcnt(0)" ::: "memory");
    __syncthreads();
    if (threadIdx.x == 0) {
        unsigned* bar = b.bar;
        __builtin_amdgcn_s_waitcnt(0);
        unsigned nloc = b.st[0], nx = b.st[1];
        if (nloc == 0u) { xcd_barrier_complete(bar, b.x, nloc, nx); b.st[0] = nloc; b.st[1] = nx; }
        const unsigned old = xb_add(&bar[XB_XSUB(b.x)], 1u);
        const unsigned gen = old / nloc;
        if (old + 1u == (gen + 1u) * nloc) {
            __builtin_amdgcn_fence(__ATOMIC_RELEASE, "agent");
            asm volatile("s_waitcnt vmcnt(0)" ::: "memory");
            const unsigned og = xb_add(&bar[XB_TOP], 1u);
            const unsigned tg = og / nx;
            if (og + 1u == (tg + 1u) * nx) xb_add(&bar[XB_TOPGEN], 1u);
            else XB_SPIN(xb_ld(&bar[XB_TOPGEN]) == tg, bar);
            __builtin_amdgcn_fence(__ATOMIC_ACQUIRE, "agent");
            xb_add(&bar[XB_XGEN(b.x)], 1u);
            asm volatile("s_waitcnt vmcnt(0)" ::: "memory");
        } else {
            XB_SPIN(xb_ld(&bar[XB_XGEN(b.x)]) == gen, bar);
            __builtin_amdgcn_fence(__ATOMIC_ACQUIRE, "agent");
            asm volatile("s_waitcnt vmcnt(0)" ::: "memory");
        }
    }
    __syncthreads();
}
struct Frame {
    LAS unsigned char* lds;
    volatile LAS unsigned* MISC;
    gu32* ctl;
    int tid, lane, wave;
    int vcu, G;
};
__device__ __forceinline__ float wave_sum(float v) {
#pragma unroll
    for (int o = 1; o < 64; o <<= 1) v += __shfl_xor(v, o);
    return v;
}
__device__ __forceinline__ float bf_lo(unsigned w) { return __uint_as_float(w << 16); }
__device__ __forceinline__ float bf_hi(unsigned w) { return __uint_as_float(w & 0xffff0000u); }
__device__ __forceinline__ float fsigmoid(float x) { return __builtin_amdgcn_rcpf(1.0f + __expf(-x)); }

__device__ __forceinline__ void p0_item(const float* W, int Ksrc, int Nsrc, int scol, const float* gain, bf16* WT, int Kd, int drow, int k0, LAS float* scr, int lane) {
#pragma unroll 8
    for (int i = 0; i < 32; ++i) { const int kk = 2 * i + (lane >> 5); const int kg = k0 + kk;
        float v = 0.f; if (scol >= 0 && kg < Ksrc) { v = W[(size_t)kg * Nsrc + scol + (lane & 31)]; if (gain) v *= gain[kg]; }
        scr[kk * 33 + (lane & 31)] = v; }
    LDS_WAIT(); asm volatile("" ::: "memory");
    const int c = lane & 7;
#pragma unroll
    for (int j = 0; j < 4; ++j) { const int n = (lane >> 3) + 8 * j; const LAS float* s = scr + (8 * c) * 33 + n;
        v4u o; o.x = pk2(s[0 * 33], s[1 * 33]); o.y = pk2(s[2 * 33], s[3 * 33]); o.z = pk2(s[4 * 33], s[5 * 33]); o.w = pk2(s[6 * 33], s[7 * 33]);
        *(GAS v4u*)(WT + (size_t)(drow + n) * Kd + k0 + 8 * c) = o; }
    LDS_WAIT(); asm volatile("" ::: "memory");
}
__device__ __forceinline__ int map_ffn_in(int db) { const int n = 32 * db, pn = n >> 8, bj = (n >> 7) & 1, jj = n & 127; return bj * FF + 128 * pn + jj; }
__device__ __forceinline__ int map_mix(int db) {
    const int pn = db >> 3, w = db & 7, bj = w >> 2, wc = w & 3;
    if (pn < 12) return 256 * pn + 32 * w;
    if (pn < 14) { const int c = (pn - 12) * 256 + 32 * w; return c < 288 ? 3072 + c : -1; }
    if (pn < 20) { const int isk = (pn - 14) / 3, tt = (pn - 14) % 3; return RW_COLS + isk * AW + (4 * tt + wc) * 64 + bj * 32; }
    return RW_COLS + 2 * AW + (pn - 20) * 256 + 32 * w;
}
__device__ __forceinline__ int map_g2(int db) { const int pn = db >> 3, w = db & 7, bj = w >> 2, wc = w & 3; return (4 * pn + wc) * 64 + bj * 32; }

struct P0Args { const float* in[26]; unsigned char* ws; float* out; };
__device__ __forceinline__ void p0_prologue(Frame& F, const P0Args& A) {
    LAS float* scr = (LAS float*)(F.lds + RING_OFF + F.wave * 16384);
    const int gw = F.vcu * NWAVES + F.wave, NGW = F.G * NWAVES;
    unsigned char* ws = A.ws;
    constexpr int J_W1 = 176 * 16, J_W2 = 32 * 44, J_WIN = 184 * 16, J_WG = 64 * 16, J_WA = 32 * 16, J_WB = 32 * 12, J_WO = 32 * 16, J_G2 = 32 * 4, J_L2 = 32 * 1;
    constexpr int NITEMS = 2 * J_W1 + 2 * J_W2 + J_WIN + J_WG + J_WA + J_WB + J_WO + J_G2 + 2 * J_L2;
    for (int it = gw; it < NITEMS; it += NGW) {
        int r = it;
        if (r < J_W1) { const int db = r % 176, kb = r / 176; p0_item(A.in[2], D, 2 * FF, map_ffn_in(db), A.in[1], (bf16*)(ws + WS_W1T), D, 32 * db, 64 * kb, scr, F.lane); continue; } r -= J_W1;
        if (r < J_W1) { const int db = r % 176, kb = r / 176; p0_item(A.in[24], D, 2 * FF, map_ffn_in(db), A.in[23], (bf16*)(ws + WS_W3T), D, 32 * db, 64 * kb, scr, F.lane); continue; } r -= J_W1;
        if (r < J_W2) { const int db = r % 32, kb = r / 32; p0_item(A.in[3], FF, D, 32 * db, nullptr, (bf16*)(ws + WS_W2T), FF, 32 * db, 64 * kb, scr, F.lane); continue; } r -= J_W2;
        if (r < J_W2) { const int db = r % 32, kb = r / 32; p0_item(A.in[25], FF, D, 32 * db, nullptr, (bf16*)(ws + WS_W4T), FF, 32 * db, 64 * kb, scr, F.lane); continue; } r -= J_W2;
        if (r < J_WIN) { const int db = r % 184, kb = r / 184; p0_item(A.in[5], D, IN_COLS, map_mix(db), A.in[4], (bf16*)(ws + WS_WIN), D, 32 * db, 64 * kb, scr, F.lane); continue; } r -= J_WIN;
        if (r < J_WG) { const int db = r % 64, kb = r / 64; p0_item(A.in[5], D, IN_COLS, RW_COLS + 3 * AW + 32 * db, A.in[4], (bf16*)(ws + WS_WG), D, 32 * db, 64 * kb, scr, F.lane); continue; } r -= J_WG;
        if (r < J_WA) { const int db = r % 32, kb = r / 32; p0_item(A.in[20], D, D, 32 * db, nullptr, (bf16*)(ws + WS_WA), D, 32 * db, 64 * kb, scr, F.lane); continue; } r -= J_WA;
        if (r < J_WB) { const int db = r % 32, kb = r / 32; p0_item(A.in[21], AW, D, 32 * db, nullptr, (bf16*)(ws + WS_WB), AW, 32 * db, 64 * kb, scr, F.lane); continue; } r -= J_WB;
        if (r < J_WO) { const int db = r % 32, kb = r / 32; p0_item(A.in[22], D, D, 32 * db, nullptr, (bf16*)(ws + WS_WO), D, 32 * db, 64 * kb, scr, F.lane); continue; } r -= J_WO;
        if (r < J_G2) { const int db = r % 32, kb = r / 32; p0_item(A.in[12], 160, D, map_g2(db), nullptr, (bf16*)(ws + WS_G2T), 256, 32 * db, 64 * kb, scr, F.lane); continue; } r -= J_G2;
        if (r < J_L2) { p0_item(A.in[9], 64, D, 32 * r, nullptr, (bf16*)(ws + WS_L2T), 64, 32 * r, 0, scr, F.lane); continue; } r -= J_L2;
        p0_item(A.in[11], 64, D, 32 * r, nullptr, (bf16*)(ws + WS_L2T + 131072), 64, 32 * r, 0, scr, F.lane);
    }
    bf16* xb0 = (bf16*)A.out; float* ss0 = (float*)(ws + WS_SS0); const float* x = A.in[0];
    for (int m = gw; m < M; m += NGW) {
        const GAS f32x4* xr = (const GAS f32x4*)(x + (size_t)m * D) + F.lane;
        f32x4 v[4]; float s = 0.f;
#pragma unroll
        for (int j = 0; j < 4; ++j) { v[j] = xr[64 * j]; s += (v[j].x * v[j].x + v[j].y * v[j].y) + (v[j].z * v[j].z + v[j].w * v[j].w); }
        s = wave_sum(s);
        GAS unsigned long long* o8 = (GAS unsigned long long*)(xb0 + (size_t)m * D) + F.lane;
#pragma unroll
        for (int j = 0; j < 4; ++j) o8[64 * j] = (unsigned long long)pk2(v[j].x, v[j].y) | ((unsigned long long)pk2(v[j].z, v[j].w) << 32);
        if (F.lane < 16) ss0[(size_t)m * 16 + F.lane] = F.lane == 0 ? s : 0.f;
    }
}

typedef short v4i16_t __attribute__((ext_vector_type(4)));
typedef unsigned v2u __attribute__((ext_vector_type(2)));
__device__ __forceinline__ bf16x8 vtr2(const LAS unsigned char* p0, const LAS unsigned char* p1) {
    const v4i16_t a = __builtin_amdgcn_ds_read_tr16_b64_v4i16((LAS v4i16_t*)p0), b = __builtin_amdgcn_ds_read_tr16_b64_v4i16((LAS v4i16_t*)p1);
    return (bf16x8){a[0], a[1], a[2], a[3], b[0], b[1], b[2], b[3]};
}
constexpr int ATT_LDK = 144;
constexpr int ATT_V_OFF = 256 * ATT_LDK;
__device__ __forceinline__ void attn_unit(Frame& F, int unit, const bf16* AQ, const bf16* AK, const bf16* AV, bf16* O, float* LSE) {
    const int b = unit / 384, rem = unit % 384, head = rem >> 5, idx = rem & 31;
    const int g = head >> 2; const int dsh = 2 * g;
    const int nbs = 5 - dsh;
    const int c = idx >> nbs, n = idx & ((1 << nbs) - 1);
    LAS unsigned char* Kl = F.lds + RING_OFF; LAS unsigned char* Vl = Kl + ATT_V_OFF;
    const int tid = F.tid, lane = F.lane, w = F.wave, l15 = lane & 15, gq = lane >> 4;
    {
        const int row = tid >> 1, hf = tid & 1; const int sp = (n - 1) * 128 + row;
        v4u kv[4], vv[4];
        if (sp >= 0) {
            const size_t tok = (size_t)b * SEQ + ((size_t)sp << dsh) + c; const size_t off = tok * AW + head * 64 + hf * 32;
            const GAS v4u* kp = (const GAS v4u*)(AK + off); const GAS v4u* vp = (const GAS v4u*)(AV + off);
#pragma unroll
            for (int i = 0; i < 4; ++i) { kv[i] = kp[i]; vv[i] = vp[i]; }
        } else {
#pragma unroll
            for (int i = 0; i < 4; ++i) { kv[i] = (v4u){0u, 0u, 0u, 0u}; vv[i] = kv[i]; }
        }
#pragma unroll
        for (int i = 0; i < 4; ++i) { *(LAS v4u*)(Kl + row * ATT_LDK + hf * 64 + i * 16) = kv[i]; *(LAS v4u*)(Vl + row * ATT_LDK + hf * 64 + i * 16) = vv[i]; }
    }
    const int qi = 16 * w + l15; const size_t qtok = (size_t)b * SEQ + ((size_t)(n * 128 + qi) << dsh) + c;
    const bf16x8 qf0 = *(const GAS bf16x8*)(AQ + qtok * AW + head * 64 + 8 * gq), qf1 = *(const GAS bf16x8*)(AQ + qtok * AW + head * 64 + 32 + 8 * gq);
    __syncthreads();
    f32x4 S[9];
#pragma unroll
    for (int kt = 0; kt < 9; ++kt) {
        const LAS unsigned char* kr = Kl + (16 * (w + kt) + l15) * ATT_LDK + 16 * gq;
        const bf16x8 k0 = *(const LAS bf16x8*)kr, k1 = *(const LAS bf16x8*)(kr + 64);
        f32x4 a = (f32x4){0.f, 0.f, 0.f, 0.f};
        a = __builtin_amdgcn_mfma_f32_16x16x32_bf16(k0, qf0, a, 0, 0, 0);
        a = __builtin_amdgcn_mfma_f32_16x16x32_bf16(k1, qf1, a, 0, 0, 0);
        S[kt] = a;
    }
    float mx = -1e30f;
#pragma unroll
    for (int kt = 0; kt < 9; ++kt)
#pragma unroll
        for (int r = 0; r < 4; ++r) { const int j = 16 * (w + kt) + 4 * gq + r; const int dist = qi + 128 - j;
            const bool ok = dist >= 0 && dist <= 128 && (n > 0 || j >= 128);
            S[kt][r] = ok ? S[kt][r] : -1e30f; mx = fmaxf(mx, S[kt][r]); }
    mx = fmaxf(mx, __shfl_xor(mx, 16)); mx = fmaxf(mx, __shfl_xor(mx, 32));
    float den = 0.f;
#pragma unroll
    for (int kt = 0; kt < 9; ++kt)
#pragma unroll
        for (int r = 0; r < 4; ++r) { const float p = __builtin_amdgcn_exp2f(S[kt][r] - mx); S[kt][r] = p; den += p; }
    den += __shfl_xor(den, 16); den += __shfl_xor(den, 32);
    f32x4 Oa[4];
#pragma unroll
    for (int et = 0; et < 4; ++et) Oa[et] = (f32x4){0.f, 0.f, 0.f, 0.f};
    const int q4 = l15 >> 2, p4 = l15 & 3;
#pragma unroll
    for (int pp = 0; pp < 5; ++pp) {
        const int kt0 = 2 * pp, kt1 = (pp < 4) ? 2 * pp + 1 : 8;
        const f32x4 Pa = S[kt0]; const f32x4 Pb = (pp < 4) ? S[kt1] : (f32x4){0.f, 0.f, 0.f, 0.f};
        v4u pw; pw.x = pg8::cvt_pk_bf16(Pa[0], Pa[1]); pw.y = pg8::cvt_pk_bf16(Pa[2], Pa[3]); pw.z = pg8::cvt_pk_bf16(Pb[0], Pb[1]); pw.w = pg8::cvt_pk_bf16(Pb[2], Pb[3]);
        const bf16x8 pb = __builtin_bit_cast(bf16x8, pw);
        const LAS unsigned char* v0 = Vl + (16 * (w + kt0) + 4 * gq + q4) * ATT_LDK + 8 * p4;
        const LAS unsigned char* v1 = Vl + (16 * (w + kt1) + 4 * gq + q4) * ATT_LDK + 8 * p4;
#pragma unroll
        for (int et = 0; et < 4; ++et) { const bf16x8 va = vtr2(v0 + 32 * et, v1 + 32 * et); Oa[et] = __builtin_amdgcn_mfma_f32_16x16x32_bf16(va, pb, Oa[et], 0, 0, 0); }
    }
    const float inv = 1.0f / den;
    bf16* op = O + qtok * AW + head * 64 + 4 * gq;
#pragma unroll
    for (int et = 0; et < 4; ++et) { const f32x4 o = Oa[et] * inv; unsigned long long w2 = (unsigned long long)pg8::cvt_pk_bf16(o[0], o[1]) | ((unsigned long long)pg8::cvt_pk_bf16(o[2], o[3]) << 32);
        *(GAS unsigned long long*)(op + 16 * et) = w2; }
    if (gq == 0) LSE[qtok * NHA + head] = mx + __builtin_amdgcn_logf(den);
    __syncthreads();
}

__device__ __forceinline__ float dpp_sum16(float v) {
    v += __builtin_bit_cast(float, __builtin_amdgcn_update_dpp(0, __builtin_bit_cast(int, v), 0xB1, 0xF, 0xF, true));
    v += __builtin_bit_cast(float, __builtin_amdgcn_update_dpp(0, __builtin_bit_cast(int, v), 0x4E, 0xF, 0xF, true));
    v += __builtin_bit_cast(float, __builtin_amdgcn_update_dpp(0, __builtin_bit_cast(int, v), 0x141, 0xF, 0xF, true));
    v += __builtin_bit_cast(float, __builtin_amdgcn_update_dpp(0, __builtin_bit_cast(int, v), 0x140, 0xF, 0xF, true));
    return v;
}
constexpr int SC_T = 32;
constexpr int SC_BUF = 5 * SC_T * 64 * 4 + SC_T * 32 * 4;
constexpr int SC_YB = SC_T * 32 * 4;
constexpr int SC_OFF_Y = 2 * SC_BUF;
constexpr int SC_OFF_LW = SC_OFF_Y + 2 * SC_YB;
constexpr int SC_OFF_CST = SC_OFF_LW + 2 * 64 * 144;
constexpr int SC_END = SC_OFF_CST + 608 * 4;
static_assert(SC_END <= RING_BYTES, "scan LDS");
struct ScanArgs { const bf16 *pr, *pk, *pv, *plora; const bf16* l2t; const float *mu, *w0, *a0, *kk, *ka, *rk; bf16* wkv; float* bonus; };

__device__ __forceinline__ void scan_prep(Frame& F, const ScanArgs& A, int b, int h, int half, int chunk, LAS unsigned char* buf) {
    const int pw = F.wave - 4, lane = F.lane, tt = lane & 15, g = lane >> 4;
    const int tl = 16 * pw + tt; const int tseq = chunk * SC_T + tl; const size_t gt = (size_t)b * SEQ + tseq; const bool hp = tseq > 0;
    const LAS float* cst = (const LAS float*)(F.lds + RING_OFF + SC_OFF_CST);
    bf16x8 bw[2], ba[2];
#pragma unroll
    for (int ks = 0; ks < 2; ++ks) {
        const int j0 = 8 * g + 32 * ks;
        const v4u cw = *(const GAS v4u*)(A.plora + gt * 288 + j0), ca = *(const GAS v4u*)(A.plora + gt * 288 + 64 + j0);
        v4u pwv = (v4u){0u, 0u, 0u, 0u}, pav = pwv;
        if (hp) { pwv = *(const GAS v4u*)(A.plora + (gt - 1) * 288 + j0); pav = *(const GAS v4u*)(A.plora + (gt - 1) * 288 + 64 + j0); }
        v4u ow, oa;
#pragma unroll
        for (int e2 = 0; e2 < 4; ++e2) {
            const float muw0 = cst[j0 + 2 * e2], muw1 = cst[j0 + 2 * e2 + 1], mua0 = cst[64 + j0 + 2 * e2], mua1 = cst[64 + j0 + 2 * e2 + 1];
            float w0_ = bf_lo(cw[e2]), w1_ = bf_hi(cw[e2]), a0_ = bf_lo(ca[e2]), a1_ = bf_hi(ca[e2]);
            w0_ += (bf_lo(pwv[e2]) - w0_) * muw0; w1_ += (bf_hi(pwv[e2]) - w1_) * muw1; a0_ += (bf_lo(pav[e2]) - a0_) * mua0; a1_ += (bf_hi(pav[e2]) - a1_) * mua1;
            w0_ = 1.0f - 2.0f * __builtin_amdgcn_rcpf(1.0f + __expf(2.0f * w0_)); w1_ = 1.0f - 2.0f * __builtin_amdgcn_rcpf(1.0f + __expf(2.0f * w1_));
            ow[e2] = pk2(w0_, w1_); oa[e2] = pk2(a0_, a1_);
        }
        bw[ks] = __builtin_bit_cast(bf16x8, ow); ba[ks] = __builtin_bit_cast(bf16x8, oa);
    }
    const LAS unsigned char* lw = F.lds + RING_OFF + SC_OFF_LW;
    f32x4 accw[4], acca[4];
#pragma unroll
    for (int nt = 0; nt < 4; ++nt) {
        accw[nt] = (f32x4){0.f, 0.f, 0.f, 0.f}; acca[nt] = accw[nt];
#pragma unroll
        for (int ks = 0; ks < 2; ++ks) {
            const bf16x8 fw = *(const LAS bf16x8*)(lw + (16 * nt + tt) * 144 + (8 * g + 32 * ks) * 2);
            const bf16x8 fa = *(const LAS bf16x8*)(lw + 64 * 144 + (16 * nt + tt) * 144 + (8 * g + 32 * ks) * 2);
            accw[nt] = __builtin_amdgcn_mfma_f32_16x16x32_bf16(fw, bw[ks], accw[nt], 0, 0, 0);
            acca[nt] = __builtin_amdgcn_mfma_f32_16x16x32_bf16(fa, ba[ks], acca[nt], 0, 0, 0);
        }
    }
    float rs[4][4], ks_[4][4], kkv[4][4], av[4][4], dec[4][4];
    float ssq = 0.f;
#pragma unroll
    for (int nt = 0; nt < 4; ++nt) {
        const int c0 = 16 * nt + 4 * g;
        const v2u cr = *(const GAS v2u*)(A.pr + gt * 1024 + h * 64 + c0), ck = *(const GAS v2u*)(A.pk + gt * 1024 + h * 64 + c0);
        v2u pr_ = (v2u){0u, 0u}, pk_ = pr_;
        if (hp) { pr_ = *(const GAS v2u*)(A.pr + (gt - 1) * 1024 + h * 64 + c0); pk_ = *(const GAS v2u*)(A.pk + (gt - 1) * 1024 + h * 64 + c0); }
        const float rc[4] = {bf_lo(cr.x), bf_hi(cr.x), bf_lo(cr.y), bf_hi(cr.y)}, rp[4] = {bf_lo(pr_.x), bf_hi(pr_.x), bf_lo(pr_.y), bf_hi(pr_.y)};
        const float kc[4] = {bf_lo(ck.x), bf_hi(ck.x), bf_lo(ck.y), bf_hi(ck.y)}, kp[4] = {bf_lo(pk_.x), bf_hi(pk_.x), bf_lo(pk_.y), bf_hi(pk_.y)};
#pragma unroll
        for (int i = 0; i < 4; ++i) {
            const int c = c0 + i;
            rs[nt][i] = rc[i] + (rp[i] - rc[i]) * cst[128 + c];
            ks_[nt][i] = kc[i] + (kp[i] - kc[i]) * cst[192 + c];
            const float wl = cst[288 + c] + accw[nt][i], al = cst[352 + c] + acca[nt][i];
            dec[nt][i] = __expf(-0.6065306597126334f * fsigmoid(wl));
            av[nt][i] = fsigmoid(al);
            kkv[nt][i] = ks_[nt][i] * cst[416 + c]; ssq += kkv[nt][i] * kkv[nt][i];
        }
    }
    ssq += __shfl_xor(ssq, 16); ssq += __shfl_xor(ssq, 32);
    const float inv = 1.0f / fmaxf(sqrtf(ssq), 1e-12f);
    float bon = 0.f;
    LAS float* Wb = (LAS float*)buf; LAS float* Ab = Wb + SC_T * 64; LAS float* Bb = Ab + SC_T * 64; LAS float* Kb = Bb + SC_T * 64; LAS float* Rb = Kb + SC_T * 64; LAS float* Vb = Rb + SC_T * 64;
#pragma unroll
    for (int nt = 0; nt < 4; ++nt) {
        const int c0 = 16 * nt + 4 * g; f32x4 ow, oa, ob, ok, orr;
#pragma unroll
        for (int i = 0; i < 4; ++i) {
            const int c = c0 + i; const float kn = kkv[nt][i] * inv; const float km = ks_[nt][i] * (1.0f + (av[nt][i] - 1.0f) * cst[480 + c]);
            ow[i] = dec[nt][i]; oa[i] = -kn; ob[i] = kn * av[nt][i]; ok[i] = km; orr[i] = rs[nt][i];
            bon += rs[nt][i] * km * cst[544 + c];
        }
        *(LAS f32x4*)(Wb + tl * 64 + c0) = ow; *(LAS f32x4*)(Ab + tl * 64 + c0) = oa; *(LAS f32x4*)(Bb + tl * 64 + c0) = ob; *(LAS f32x4*)(Kb + tl * 64 + c0) = ok; *(LAS f32x4*)(Rb + tl * 64 + c0) = orr;
    }
    bon += __shfl_xor(bon, 16); bon += __shfl_xor(bon, 32);
    if (half == 0 && g == 0) A.bonus[gt * 16 + h] = bon;
    {
        const int r0 = 8 * g; const size_t off = gt * 1024 + h * 64 + half * 32 + r0;
        const v4u cv = *(const GAS v4u*)(A.pv + off); v4u pvv = (v4u){0u, 0u, 0u, 0u}; if (hp) pvv = *(const GAS v4u*)(A.pv + off - 1024);
        f32x4 o0, o1;
#pragma unroll
        for (int e2 = 0; e2 < 4; ++e2) {
            float a = bf_lo(cv[e2]), bq = bf_hi(cv[e2]);
            a += (bf_lo(pvv[e2]) - a) * cst[256 + r0 + 2 * e2]; bq += (bf_hi(pvv[e2]) - bq) * cst[256 + r0 + 2 * e2 + 1];
            if (e2 < 2) { o0[2 * e2] = a; o0[2 * e2 + 1] = bq; } else { o1[2 * (e2 - 2)] = a; o1[2 * (e2 - 2) + 1] = bq; }
        }
        *(LAS f32x4*)(Vb + tl * 32 + r0) = o0; *(LAS f32x4*)(Vb + tl * 32 + r0 + 4) = o1;
    }
}

typedef float f32x2v __attribute__((ext_vector_type(2)));
__device__ __forceinline__ void scan_unit(Frame& F, const ScanArgs& A, int unit) {
    const int b = unit >> 5, h = (unit >> 1) & 15, half = unit & 1;
    LAS unsigned char* base = F.lds + RING_OFF;
    const int tid = F.tid, lane = F.lane, w = F.wave;
    {
        LAS float* cst = (LAS float*)(base + SC_OFF_CST);
        for (int i = tid; i < 608; i += 512) {
            float v;
            if (i < 64) v = A.mu[3072 + i]; else if (i < 128) v = A.mu[3136 + (i - 64)]; else if (i < 192) v = A.mu[h * 64 + (i - 128)]; else if (i < 256) v = A.mu[1024 + h * 64 + (i - 192)];
            else if (i < 288) v = A.mu[2048 + h * 64 + half * 32 + (i - 256)]; else if (i < 352) v = A.w0[h * 64 + (i - 288)]; else if (i < 416) v = A.a0[h * 64 + (i - 352)];
            else if (i < 480) v = A.kk[h * 64 + (i - 416)]; else if (i < 544) v = A.ka[h * 64 + (i - 480)]; else v = A.rk[h * 64 + (i - 544)];
            cst[i] = v;
        }
        for (int i = tid; i < 1024; i += 512) { const int mat = i >> 9, rr = (i >> 3) & 63, ch = i & 7;
            const v4u v = *(const GAS v4u*)(A.l2t + (size_t)mat * 65536 + (size_t)(h * 64 + rr) * 64 + ch * 8);
            *(LAS v4u*)(base + SC_OFF_LW + mat * 64 * 144 + rr * 144 + ch * 16) = v; }
    }
    __syncthreads();
    constexpr int NCH = SEQ / SC_T;
    if (w == 4 || w == 5) scan_prep(F, A, b, h, half, 0, base);
    __syncthreads();
    f32x2v St[4];
#pragma unroll
    for (int j = 0; j < 4; ++j) St[j] = (f32x2v){0.f, 0.f};
    const int rp = lane >> 4, kq = lane & 15;
    for (int p = 0; p < NCH; ++p) {
        LAS unsigned char* cur = base + (p & 1) * SC_BUF;
        if (w < 4) {
            const LAS float* Wb = (const LAS float*)cur; const LAS float* Ab = Wb + SC_T * 64; const LAS float* Bb = Ab + SC_T * 64; const LAS float* Kb = Bb + SC_T * 64; const LAS float* Rb = Kb + SC_T * 64; const LAS float* Vb = Rb + SC_T * 64;
            LAS float* Yb = (LAS float*)(base + SC_OFF_Y + (p & 1) * SC_YB);
            const int ko = 4 * kq, vo = 8 * w + 2 * rp;
            f32x4 W4 = *(const LAS f32x4*)(Wb + ko), A4 = *(const LAS f32x4*)(Ab + ko), B4 = *(const LAS f32x4*)(Bb + ko), K4 = *(const LAS f32x4*)(Kb + ko), R4 = *(const LAS f32x4*)(Rb + ko);
            f32x2v V2 = *(const LAS f32x2v*)(Vb + vo);
#pragma unroll 4
            for (int t = 0; t < SC_T; ++t) {
                const int tn = (t + 1 < SC_T) ? t + 1 : t;
                const f32x4 nW = *(const LAS f32x4*)(Wb + tn * 64 + ko), nA = *(const LAS f32x4*)(Ab + tn * 64 + ko), nB = *(const LAS f32x4*)(Bb + tn * 64 + ko), nK = *(const LAS f32x4*)(Kb + tn * 64 + ko), nR = *(const LAS f32x4*)(Rb + tn * 64 + ko);
                const f32x2v nV = *(const LAS f32x2v*)(Vb + tn * 32 + vo);
                f32x2v sa = St[0] * A4[0]; sa += St[1] * A4[1]; sa += St[2] * A4[2]; sa += St[3] * A4[3];
                sa.x = dpp_sum16(sa.x); sa.y = dpp_sum16(sa.y);
#pragma unroll
                for (int j = 0; j < 4; ++j) { const f32x2v tmp = V2 * K4[j] + sa * B4[j]; St[j] = St[j] * W4[j] + tmp; }
                f32x2v y = St[0] * R4[0]; y += St[1] * R4[1]; y += St[2] * R4[2]; y += St[3] * R4[3];
                y.x = dpp_sum16(y.x); y.y = dpp_sum16(y.y);
                if (kq == 0) *(LAS f32x2v*)(Yb + t * 32 + vo) = y;
                W4 = nW; A4 = nA; B4 = nB; K4 = nK; R4 = nR; V2 = nV;
            }
        } else if (w < 6) {
            if (p + 1 < NCH) scan_prep(F, A, b, h, half, p + 1, base + ((p + 1) & 1) * SC_BUF);
        } else if (p >= 1) {
            const int i = (w - 6) * 64 + lane, tk = i >> 2, r0 = (i & 3) * 8;
            const LAS float* Yp = (const LAS float*)(base + SC_OFF_Y + ((p - 1) & 1) * SC_YB) + tk * 32 + r0;
            const f32x4 y0 = *(const LAS f32x4*)Yp, y1 = *(const LAS f32x4*)(Yp + 4);
            v4u o; o.x = pk2(y0[0], y0[1]); o.y = pk2(y0[2], y0[3]); o.z = pk2(y1[0], y1[1]); o.w = pk2(y1[2], y1[3]);
            *(GAS v4u*)(A.wkv + ((size_t)b * SEQ + (size_t)(p - 1) * SC_T + tk) * 1024 + h * 64 + half * 32 + r0) = o;
        }
        __syncthreads();
    }
    if (w >= 6) {
        const int p = NCH; const int i = (w - 6) * 64 + lane, tk = i >> 2, r0 = (i & 3) * 8;
        const LAS float* Yp = (const LAS float*)(base + SC_OFF_Y + ((p - 1) & 1) * SC_YB) + tk * 32 + r0;
        const f32x4 y0 = *(const LAS f32x4*)Yp, y1 = *(const LAS f32x4*)(Yp + 4);
        v4u o; o.x = pk2(y0[0], y0[1]); o.y = pk2(y0[2], y0[3]); o.z = pk2(y1[0], y1[1]); o.w = pk2(y1[2], y1[3]);
        *(GAS v4u*)(A.wkv + ((size_t)b * SEQ + (size_t)(p - 1) * SC_T + tk) * 1024 + h * 64 + half * 32 + r0) = o;
    }
    __syncthreads();
}

__device__ __forceinline__ void alpha_pass(Frame& F, bf16* O, const float* LSE) {
    const size_t nitems = (size_t)M * 96; const size_t stride = (size_t)F.G * 512;
    for (size_t it = (size_t)F.vcu * 512 + F.tid; it < nitems; it += stride) {
        const size_t t = it / 96; const int c8 = (int)(it % 96); const int head = c8 >> 3, g = head >> 2, hg = head & 3;
        const float l0 = LSE[t * NHA + hg], l1 = LSE[t * NHA + 4 + hg], l2 = LSE[t * NHA + 8 + hg];
        const float mx = fmaxf(l0, fmaxf(l1, l2));
        const float e0 = __builtin_amdgcn_exp2f(l0 - mx), e1 = __builtin_amdgcn_exp2f(l1 - mx), e2 = __builtin_amdgcn_exp2f(l2 - mx);
        const float al = (g == 0 ? e0 : (g == 1 ? e1 : e2)) / (e0 + e1 + e2);
        GAS v4u* p = (GAS v4u*)(O + t * AW + c8 * 8); const v4u v = *p; v4u o;
#pragma unroll
        for (int i = 0; i < 4; ++i) o[i] = pk2(bf_lo(v[i]) * al, bf_hi(v[i]) * al);
        *p = o;
    }
}
__device__ __forceinline__ void sgd_pass(Frame& F, const bf16* plora, const float* mu, bf16* sgd) {
    const size_t nitems = (size_t)M * 32; const size_t stride = (size_t)F.G * 512;
    for (size_t it = (size_t)F.vcu * 512 + F.tid; it < nitems; it += stride) {
        const size_t t = it >> 5; const int j0 = (int)(it & 31) * 8; v4u o = (v4u){0u, 0u, 0u, 0u};
        if (j0 < 160) {
            const v4u cv = *(const GAS v4u*)(plora + t * 288 + 128 + j0); v4u pv = (v4u){0u, 0u, 0u, 0u};
            if ((t & (SEQ - 1)) != 0) pv = *(const GAS v4u*)(plora + (t - 1) * 288 + 128 + j0);
#pragma unroll
            for (int i = 0; i < 4; ++i) { float a = bf_lo(cv[i]), bq = bf_hi(cv[i]); a += (bf_lo(pv[i]) - a) * mu[3200 + j0 + 2 * i]; bq += (bf_hi(pv[i]) - bq) * mu[3200 + j0 + 2 * i + 1];
                o[i] = pk2(fsigmoid(a), fsigmoid(bq)); }
        }
        *(GAS v4u*)(sgd + t * 256 + j0) = o;
    }
}

#define P_(T, off) ((T*)(ws + (off)))
#define xb0 ((bf16*)out)
#define W1T P_(bf16, WS_W1T)
#define W2T P_(bf16, WS_W2T)
#define WIN P_(bf16, WS_WIN)
#define WG P_(bf16, WS_WG)
#define WA P_(bf16, WS_WA)
#define WB P_(bf16, WS_WB)
#define WO P_(bf16, WS_WO)
#define G2T P_(bf16, WS_G2T)
#define W3T P_(bf16, WS_W3T)
#define W4T P_(bf16, WS_W4T)
#define L2T P_(bf16, WS_L2T)
#define SS0 P_(float, WS_SS0)
#define SS1 P_(float, WS_SS1)
#define SS2 P_(float, WS_SS2)
#define LSE P_(float, WS_LSE)
#define BON P_(float, WS_BON)
#define ACT P_(bf16, WS_ACT)
#define PR P_(bf16, WS_PR)
#define PK P_(bf16, WS_PK)
#define PV P_(bf16, WS_PV)
#define GATES P_(bf16, WS_GATES)
#define LORA P_(bf16, WS_LORA)
#define AQ P_(bf16, WS_AQ)
#define AK P_(bf16, WS_AK)
#define AV P_(bf16, WS_AV)
#define WKV P_(bf16, WS_WKV)
#define SGD P_(bf16, WS_SGD)
#define XB1 P_(bf16, WS_XB1)
#define MRG P_(bf16, WS_MRG)
#define XB2 P_(bf16, WS_XB2)
struct Args { const float* in[26]; float* out; unsigned char* ws; int ph_lo, ph_hi, li, pad; };
__global__ void __launch_bounds__(NWAVES * 64, 2) mk_fwd(Args args) {
    extern __shared__ __attribute__((aligned(16))) unsigned char lds[];
    Frame F;
    F.lds = (LAS unsigned char*)lds;
    F.MISC = (volatile LAS unsigned*)(F.lds + MISC_OFF);
    F.tid = threadIdx.x; F.lane = F.tid & 63; F.wave = __builtin_amdgcn_readfirstlane(F.tid >> 6);
    F.G = gridDim.x; { const int bx = blockIdx.x; F.vcu = (F.G % 8 == 0) ? (bx % 8) * (F.G / 8) + bx / 8 : bx; }
    unsigned char* ws = args.ws;
    F.ctl = (gu32*)(ws + WS_CTL);
    for (int u = F.tid; u < (LDS_BYTES - LDSCTL_OFF) / 4; u += NWAVES * 64) ((LAS unsigned*)(F.lds + LDSCTL_OFF))[u] = 0u;
    __syncthreads();
    XcdBarrier bar; bar.bar = (unsigned*)(F.ctl + CW_BAR); bar.x = 0; bar.st = nullptr;
    if (N_LAUNCHES == 1) bar = xcd_barrier_post((unsigned*)(F.ctl + CW_BAR), F.MISC + 8);
#define GRID_BAR() do { if (N_LAUNCHES == 1) xcd_barrier(bar); } while (0)
    const int lo = args.ph_lo, hi = args.ph_hi;
#ifndef PHMASK
#define PHMASK 0x7ff
#endif
#define IN(k) (((PHMASK >> (k)) & 1) && lo <= (k) && (k) < hi)
#define BOTH(k) (IN(k) && IN((k) + 1))
    const float* x = args.in[0];
    float* out = args.out;
    const int cid = (int)blockIdx.x;

    if (IN(0)) { P0Args pa; for (int i = 0; i < 26; ++i) pa.in[i] = args.in[i]; pa.ws = ws; pa.out = out; p0_prologue(F, pa); if (BOTH(0)) GRID_BAR(); }
    if (IN(1)) { pg8::Gemm g{xb0, W1T, M, 2 * FF, D}; pg8::StaticOrder S; S.init(M, 2 * FF, F.G, cid); pg8::EpiSwiglu E{ACT, SS0};
        pg8::gemm_phase<pg8::EpiSwiglu, pg8::StaticOrder, true, true>(F.lds + RING_OFF, g, S, E); if (BOTH(1)) GRID_BAR(); }
    if (IN(2)) { pg8::Gemm g{ACT, W2T, M, D, FF}; pg8::StaticOrder S; S.init(M, D, F.G, cid); pg8::EpiResid<true> E{x, out, XB1, SS1, 0.5f};
        pg8::gemm_phase<pg8::EpiResid<true>, pg8::StaticOrder, true, true>(F.lds + RING_OFF, g, S, E); if (BOTH(2)) GRID_BAR(); }
    if (IN(3)) { pg8::Gemm g{XB1, WIN, M, 23 * 256, D}; pg8::StaticOrder S; S.init(M, 23 * 256, F.G, cid); pg8::EpiMix E{ws, SS1, args.in[18], args.in[19]};
        pg8::gemm_phase<pg8::EpiMix, pg8::StaticOrder, true, true>(F.lds + RING_OFF, g, S, E); if (BOTH(3)) GRID_BAR(); }
    if (IN(4)) { for (int u = cid; u < NB_ * NHA * 32; u += F.G) attn_unit(F, u, AQ, AK, AV, AQ, LSE); if (BOTH(4)) GRID_BAR(); }
    if (IN(5)) {
        ScanArgs sa{PR, PK, PV, LORA, L2T, args.in[7], args.in[8], args.in[10], args.in[13], args.in[14], args.in[15], WKV, BON};
        for (int u = cid; u < NB_ * 32; u += F.G) scan_unit(F, sa, u);
        alpha_pass(F, AQ, LSE); sgd_pass(F, LORA, args.in[7], SGD);
        if (BOTH(5)) GRID_BAR(); }
    if (IN(6)) {
#ifndef SKIP_GATES
        { pg8::Gemm g{XB1, WG, M, 2 * D, D}; pg8::StaticOrder S; S.init(M, 2 * D, F.G, cid); pg8::EpiGates E{GATES, SS1, args.in[6]};
          pg8::gemm_phase<pg8::EpiGates, pg8::StaticOrder, true, true>(F.lds + RING_OFF, g, S, E); }
#endif
#ifndef SKIP_GN
        { pg8::Gemm g{SGD, G2T, M, D, 256}; pg8::StaticOrder S; S.init(M, D, F.G, cid); pg8::EpiGn E{WKV, PV, BON, args.in[7] + 2048, args.in[16], args.in[17]};
          pg8::gemm_phase<pg8::EpiGn, pg8::StaticOrder, true, true>(F.lds + RING_OFF, g, S, E); }
#endif
        if (BOTH(6)) GRID_BAR(); }
    if (IN(7)) {
        { pg8::Gemm g{WKV, WA, M, D, D}; pg8::StaticOrder S; S.init(M, D, F.G, cid); pg8::EpiProj<false> E{MRG, GATES};
          pg8::gemm_phase<pg8::EpiProj<false>, pg8::StaticOrder, true, true>(F.lds + RING_OFF, g, S, E); }
        { pg8::Gemm g{AQ, WB, M, D, AW}; pg8::StaticOrder S; S.init(M, D, F.G, cid); pg8::EpiProj<true> E{MRG, GATES};
          pg8::gemm_phase<pg8::EpiProj<true>, pg8::StaticOrder, true, true>(F.lds + RING_OFF, g, S, E); }
        if (BOTH(7)) GRID_BAR(); }
    if (IN(8)) { pg8::Gemm g{MRG, WO, M, D, D}; pg8::StaticOrder S; S.init(M, D, F.G, cid); pg8::EpiResid<true> E{out, out, XB2, SS2, 1.0f};
        pg8::gemm_phase<pg8::EpiResid<true>, pg8::StaticOrder, true, true>(F.lds + RING_OFF, g, S, E); if (BOTH(8)) GRID_BAR(); }
    if (IN(9)) { pg8::Gemm g{XB2, W3T, M, 2 * FF, D}; pg8::StaticOrder S; S.init(M, 2 * FF, F.G, cid); pg8::EpiSwiglu E{ACT, SS2};
        pg8::gemm_phase<pg8::EpiSwiglu, pg8::StaticOrder, true, true>(F.lds + RING_OFF, g, S, E); if (BOTH(9)) GRID_BAR(); }
    if (IN(10)) { pg8::Gemm g{ACT, W4T, M, D, FF}; pg8::StaticOrder S; S.init(M, D, F.G, cid); pg8::EpiResid<false> E{out, out, nullptr, nullptr, 0.5f};
        pg8::gemm_phase<pg8::EpiResid<false>, pg8::StaticOrder, true, true>(F.lds + RING_OFF, g, S, E); }

#ifdef DBG_STAGE
    if (lo <= 11 && 11 < hi) {
        const size_t n = (size_t)M * D; const size_t stride = (size_t)F.G * 512;
        for (size_t i = (size_t)blockIdx.x * 512 + F.tid; i < n; i += stride) {
            float v = 0.f;
#define DB16(buf, cnt) v += bf_lo((unsigned)(buf)[i % (size_t)(cnt)]) ;
#define DF32(buf, cnt) v += (buf)[i % (size_t)(cnt)];
            DBG_LIST
            out[i] = v;
        }
    }
#endif
#undef IN
#undef BOTH
}

extern "C" void kernel_launch(void* const* d_in, const int* in_sizes, int n_in, void* d_out, int out_size, void* d_ws, size_t ws_size, hipStream_t stream) {
    static int grid = 0;
    if (grid == 0) {
        if (n_in != 26 || in_sizes[0] != M * D || out_size != M * D || ws_size < WS_END) { fprintf(stderr, "kernel_launch: unexpected shapes: n_in %d in0 %d out %d ws %zu (need %zu)\n", n_in, n_in > 0 ? in_sizes[0] : -1, out_size, ws_size, (size_t)WS_END); grid = -1; return; }
        int dev = 0, cus = 0, per_cu = 0;
        if (hipGetDevice(&dev) != hipSuccess || hipDeviceGetAttribute(&cus, hipDeviceAttributeMultiprocessorCount, dev) != hipSuccess) { grid = -1; return; }
        if (hipFuncSetAttribute((const void*)mk_fwd, hipFuncAttributeMaxDynamicSharedMemorySize, LDS_BYTES) != hipSuccess) { fprintf(stderr, "kernel_launch: hipFuncSetAttribute failed\n"); grid = -1; return; }
        if (hipOccupancyMaxActiveBlocksPerMultiprocessor(&per_cu, (const void*)mk_fwd, NWAVES * 64, LDS_BYTES) != hipSuccess || per_cu < 1) fprintf(stderr, "kernel_launch: occupancy query reports %d per CU\n", per_cu);
        (void)hipGetLastError();
        grid = cus;
    }
    if (grid < 0) return;
    if (hipMemsetAsync((char*)d_ws + WS_CTL, 0, CTL_ZERO_BYTES, stream) != hipSuccess) return;
    Args a{};
    for (int i = 0; i < 26; ++i) a.in[i] = (const float*)d_in[i];
    a.out = (float*)d_out; a.ws = (unsigned char*)d_ws;
    if (N_LAUNCHES == 1) { a.ph_lo = 0; a.ph_hi = NPH; a.li = 0; hipLaunchKernelGGL(mk_fwd, dim3(grid), dim3(NWAVES * 64), LDS_BYTES, stream, a); }
#ifdef DBG_STAGE
    else for (int li = 0; li < NPH + 1; ++li) {
#else
    else for (int li = 0; li < NPH; ++li) {
#endif
        a.ph_lo = li; a.ph_hi = li + 1; a.li = li; hipLaunchKernelGGL(mk_fwd, dim3(grid), dim3(NWAVES * 64), LDS_BYTES, stream, a); }
}
```

```cpp
#include <hip/hip_runtime.h>
#include <cstdio>
#include <cstdint>
constexpr int NWAVES = 8;
constexpr int NB_ = 8, SEQ = 4096, D = 1024, FF = 2816, M = NB_ * SEQ;
constexpr int RW_COLS = 3360, IN_COLS = 7712, AW = 768, NHA = 12;
constexpr int NPH = 11;
#ifndef MK_N_LAUNCHES
#define MK_N_LAUNCHES 1
#endif
constexpr int N_LAUNCHES = MK_N_LAUNCHES;

constexpr size_t MiB = 1u << 20;
constexpr size_t WS_CTL = 0, CTL_ZERO_BYTES = 64 * 1024;
constexpr size_t WS_W1T = 1 * MiB;
constexpr size_t WS_W2T = 12 * MiB;
constexpr size_t WS_WIN = 17 * MiB + 512 * 1024;
constexpr size_t WS_WG  = 29 * MiB;
constexpr size_t WS_WA  = 33 * MiB;
constexpr size_t WS_WB  = 35 * MiB;
constexpr size_t WS_WO  = 36 * MiB + 512 * 1024;
constexpr size_t WS_G2T = 38 * MiB + 512 * 1024;
constexpr size_t WS_W3T = 39 * MiB;
constexpr size_t WS_W4T = 50 * MiB;
constexpr size_t WS_L2T = 55 * MiB + 512 * 1024;
constexpr size_t WS_SS0 = 56 * MiB, WS_SS1 = 58 * MiB, WS_SS2 = 60 * MiB;
constexpr size_t WS_LSE = 62 * MiB;
constexpr size_t WS_BON = 64 * MiB;
constexpr size_t WS_ACT = 66 * MiB;
constexpr size_t WS_PR = 66 * MiB, WS_PK = 130 * MiB, WS_PV = 194 * MiB;
constexpr size_t WS_GATES = 66 * MiB;
constexpr size_t WS_LORA = 258 * MiB;
constexpr size_t WS_AQ = 276 * MiB, WS_AK = 324 * MiB, WS_AV = 372 * MiB;
constexpr size_t WS_WKV = 324 * MiB;
constexpr size_t WS_SGD = 388 * MiB;
constexpr size_t WS_XB1 = 420 * MiB;
constexpr size_t WS_MRG = 130 * MiB;
constexpr size_t WS_XB2 = 276 * MiB;
constexpr size_t WS_TWA = 484 * MiB;
constexpr size_t WS_END = 492 * MiB;
constexpr int CW_BAR = 4096, CW_SUB = 8192, CW_GRP = 8320, CW_GRPM = 8896, CW_SUB2 = 9472;

constexpr int RING_OFF = 0, RING_BYTES = 162816;
constexpr int LDSCTL_OFF = RING_BYTES, MISC_OFF = LDSCTL_OFF + 320;
constexpr int LDS_BYTES = 163840;

namespace pg8 {
#define PG8_LAS __attribute__((address_space(3)))
typedef unsigned short bf16_t;
typedef short bf16x8 __attribute__((ext_vector_type(8)));
typedef float f32x4 __attribute__((ext_vector_type(4)));
typedef unsigned u32x4 __attribute__((ext_vector_type(4)));
constexpr int BM = 256, BK = 64, HALF = 128, HTB = HALF * BK * 2  , STAGE_BYTES = 8 * HTB, NXCD = 8, WGM = 8;

__host__ __device__ __forceinline__ int lds_byte(int r, int c) { const int st = (r >> 4) * 2 + (c >> 5), rr = r & 15, cc = c & 31, ob = rr * 64 + cc * 2; return st * 1024 + (ob ^ (((ob >> 9) & 1) << 5)); }
__host__ __device__ __forceinline__ void stage_rc(int b, int& R, int& C) { const int st = b / 1024, sb = b % 1024, swz = sb ^ (((sb >> 9) & 1) << 5); R = (st >> 1) * 16 + swz / 64; C = (st & 1) * 32 + (swz % 64) / 2; }
__host__ __device__ __forceinline__ int perm32(int rho) { const int n = rho >> 4, i = rho & 15; return 8 * (i >> 2) + 4 * n + (i & 3); }

struct Unit { int pm, pn; };
struct Gemm { const bf16_t* A; const bf16_t* Bt; int M, N, K; int blk = 0; };

struct StaticOrder {
    int nM, nN, nwg, G, c;
    __host__ __device__ void init(int M, int N, int G_, int c_) { nM = M / BM; nN = N / BM; nwg = nM * nN; G = G_; c = c_; }
    __host__ __device__ bool next(int i, Unit& u) const {
        const long L = (long)i * G + c; if (L >= nwg) return false;
        int wgid = (int)L; { const int q = nwg / NXCD, r = nwg % NXCD, xcd = wgid % NXCD, off = wgid / NXCD; wgid = (xcd < r ? xcd * (q + 1) : r * (q + 1) + (xcd - r) * q) + off; }
        const int nig = WGM * nN, gid = wgid / nig, fm = gid * WGM, gsz = (nM - fm) < WGM ? (nM - fm) : WGM;
        u.pm = fm + ((wgid % nig) % gsz); u.pn = (wgid % nig) / gsz; return true;
    }
    __device__ __forceinline__ void a_ready(const Unit&) const {}
    __device__ __forceinline__ void done(const Unit&) const {}
};
struct ColsOrder : StaticOrder { int pn0; __host__ __device__ void init2(int M, int N, int G_, int c_, int pn0_) { init(M, N, G_, c_); pn0 = pn0_; }
    __host__ __device__ bool next(int i, Unit& u) const { if (!StaticOrder::next(i, u)) return false; u.pn += pn0; return true; } };
struct SkipOrder : StaticOrder { int skip; __host__ __device__ void init2(int M, int N, int G_, int c_, int skip_) { init(M, N, G_, c_); skip = skip_; }
    __host__ __device__ bool next(int i, Unit& u) const { if (!StaticOrder::next(i, u)) return false; u.pn += (u.pn >= skip) ? 1 : 0; return true; } };
struct SameTileOrder : StaticOrder { __host__ __device__ bool next(int i, Unit& u) const { Unit t; if (!StaticOrder::next(i, t)) return false; return StaticOrder::next(0, u); } };
typedef float f32x2c_t __attribute__((ext_vector_type(2))); typedef __bf16 bf16x2c_t __attribute__((ext_vector_type(2)));
__device__ __forceinline__ unsigned cvt_pk_bf16(float lo, float hi) { f32x2c_t v = {lo, hi}; bf16x2c_t b = __builtin_convertvector(v, bf16x2c_t); return __builtin_bit_cast(unsigned, b); }
typedef float f32x2 __attribute__((ext_vector_type(2)));
__device__ __forceinline__ float fast_sigmoid(float x) { return __builtin_amdgcn_rcpf(1.0f + __expf(-x)); }
__device__ __forceinline__ float row_scale_from_ss(const float* ss, int row, int fq) {
    const f32x4 a = *(const f32x4*)(ss + (size_t)row * 16 + 4 * fq);
    float s = (a[0] + a[1]) + (a[2] + a[3]);
    s += __shfl_xor(s, 16); s += __shfl_xor(s, 32);
    return __builtin_amdgcn_rsqf(s * (1.0f / 1024.0f) + 1e-6f);
}
__device__ __forceinline__ u32x4 pack8(const f32x4 a, const f32x4 b) { u32x4 w; w.x = cvt_pk_bf16(a[0], a[1]); w.y = cvt_pk_bf16(a[2], a[3]); w.z = cvt_pk_bf16(b[0], b[1]); w.w = cvt_pk_bf16(b[2], b[3]); return w; }
__device__ __forceinline__ void unpack8(const u32x4 w, f32x4& a, f32x4& b) {
    a[0] = __uint_as_float(w.x << 16); a[1] = __uint_as_float(w.x & 0xffff0000u); a[2] = __uint_as_float(w.y << 16); a[3] = __uint_as_float(w.y & 0xffff0000u);
    b[0] = __uint_as_float(w.z << 16); b[1] = __uint_as_float(w.z & 0xffff0000u); b[2] = __uint_as_float(w.w << 16); b[3] = __uint_as_float(w.w & 0xffff0000u);
}
#ifdef WT_STORES
__device__ __forceinline__ void st16(void* p, const u32x4 v) { asm volatile("global_store_dwordx4 %0, %1, off sc1\n\ts_nop 1" :: "v"(p), "v"(v) : "memory"); }
#else
__device__ __forceinline__ void st16(void* p, const u32x4 v) { *(u32x4*)p = v; }
#endif
__device__ __forceinline__ void st16f(float* p, const f32x4 v) { st16((void*)p, __builtin_bit_cast(u32x4, v)); }
constexpr int FFN_HID = 2816;
__device__ __forceinline__ size_t boff(int row, int col) { return (size_t)(row >> 8) * (256 * 1024) + (size_t)(col >> 6) * (256 * 64) + (size_t)((row & 255) * 64 + (col & 63)); }
struct PreNone {};
struct PreRows { float v[8]; };
__device__ __forceinline__ void load_rows_ss(const float* ss, const Unit& u, int wr, int fr, PreRows& P) {
#pragma unroll
    for (int ai = 0; ai < 2; ++ai)
#pragma unroll
        for (int m = 0; m < 4; ++m) P.v[4 * ai + m] = ss[u.pm * BM + ai * HALF + wr * 64 + m * 16 + fr];
}
__device__ __forceinline__ float scale_of(float ssq) { return __builtin_amdgcn_rsqf(ssq * (1.0f / 1024.0f) + 1e-6f); }

struct EpiSwiglu {
    static constexpr bool PERM = true, AFTER_DRAIN = false, TWICE_OK = true; static constexpr bool Z64 = true;
    typedef PreRows Pre;
    bf16_t* O; const float* ss;
    __device__ __forceinline__ void pre(const Unit& u, int wr, int fr, Pre& P) const { load_rows_ss(ss, u, wr, fr, P); }
    __device__ __forceinline__ void operator()(const f32x4 (&acc)[2][2][4][2], const Unit& u, int wr, int wc, int fr, int fq, const Pre& P) const {
        const int row0 = u.pm * BM + wr * 64 + fr, col0 = u.pn * 128 + wc * 32 + 8 * fq;
#pragma unroll
        for (int ai = 0; ai < 2; ++ai)
#pragma unroll
            for (int m = 0; m < 4; ++m) {
                const int row = row0 + ai * HALF + m * 16; const float s = scale_of(P.v[4 * ai + m]); const float sn = -1.4426950408889634f * s, s2 = s * s;
                f32x4 o[2];
#pragma unroll
                for (int n = 0; n < 2; ++n) {
                    const f32x4 a = acc[ai][0][m][n], b = acc[ai][1][m][n]; const f32x4 t = a * sn; f32x4 e, r;
#pragma unroll
                    for (int i = 0; i < 4; ++i) e[i] = __builtin_amdgcn_exp2f(t[i]);
                    const f32x4 d = e + 1.0f;
#pragma unroll
                    for (int i = 0; i < 4; ++i) r[i] = __builtin_amdgcn_rcpf(d[i]);
                    o[n] = (a * b) * (r * s2); }
                st16(O + (size_t)(row >> 8) * (256 * FFN_HID) + (size_t)(col0 >> 6) * (256 * 64) + (row & 255) * 64 + (col0 & 63), pack8(o[0], o[1]));
            }
    }
};

template <bool SRC_BF16, bool OUT_F32, bool OUT_BF16> struct EpiResid {
    static constexpr bool PERM = true, AFTER_DRAIN = false, TWICE_OK = false; static constexpr bool Z64 = true;
    typedef PreNone Pre;
    const void* base; float* out; bf16_t* xb; float* ss; float scale;
    __device__ __forceinline__ void pre(const Unit&, int, int, Pre&) const {}
    __device__ __forceinline__ void operator()(const f32x4 (&acc)[2][2][4][2], const Unit& u, int wr, int wc, int fr, int fq, const Pre&) const {
        const int row0 = u.pm * BM + wr * 64 + fr, col0 = u.pn * BM + wc * 32 + 8 * fq;
        u32x4 raw[2][4][2];
        if (SRC_BF16) {
#pragma unroll
            for (int ai = 0; ai < 2; ++ai)
#pragma unroll
                for (int m = 0; m < 4; ++m)
#pragma unroll
                    for (int bj = 0; bj < 2; ++bj) raw[ai][m][bj] = *(const u32x4*)((const bf16_t*)base + boff(row0 + ai * HALF + m * 16, col0 + bj * HALF));
        }
#pragma unroll
        for (int ai = 0; ai < 2; ++ai)
#pragma unroll
            for (int m = 0; m < 4; ++m) {
                const int row = row0 + ai * HALF + m * 16; const size_t off = (size_t)row * 1024 + col0; float q = 0.f;
#pragma unroll
                for (int bj = 0; bj < 2; ++bj) {
                    f32x4 b0, b1;
                    if (SRC_BF16) unpack8(raw[ai][m][bj], b0, b1);
                    else { b0 = *(const f32x4*)((const float*)base + off + bj * HALF); b1 = *(const f32x4*)((const float*)base + off + bj * HALF + 4); }
                    const f32x4 o0 = b0 + acc[ai][bj][m][0] * scale, o1 = b1 + acc[ai][bj][m][1] * scale;
                    if (OUT_F32) { __builtin_nontemporal_store(o0, (f32x4*)(out + off + bj * HALF)); __builtin_nontemporal_store(o1, (f32x4*)(out + off + bj * HALF + 4)); }
                    if (OUT_BF16) {
                        st16(xb + boff(row, col0 + bj * HALF), pack8(o0, o1));
                        q += (o0[0] * o0[0] + o0[1] * o0[1]) + (o0[2] * o0[2] + o0[3] * o0[3]) + (o1[0] * o1[0] + o1[1] * o1[1]) + (o1[2] * o1[2] + o1[3] * o1[3]);
                    }
                }
                if (OUT_BF16) { q += __shfl_xor(q, 16); q += __shfl_xor(q, 32); if (fq == 0) atomicAdd(ss + row, q); }
            }
    }
};

__device__ __forceinline__ size_t hmoff(int row, int col) { return ((size_t)((row >> 12) * 16 + (col >> 6)) * 4096 + (size_t)(row & 4095)) * 64 + (size_t)(col & 63); }
__device__ __forceinline__ size_t hm12(int row, int col) { return ((size_t)((row >> 12) * 12 + (col >> 6)) * 4096 + (size_t)(row & 4095)) * 64 + (size_t)(col & 63); }
struct EpiMix {
    static constexpr bool PERM = true, AFTER_DRAIN = false, TWICE_OK = true; static constexpr bool Z64 = true;
    typedef PreRows Pre;
    unsigned char* ws; const float* ss; const float* qgain; const float* kgain;
    __device__ __forceinline__ void pre(const Unit& u, int wr, int fr, Pre& P) const { load_rows_ss(ss, u, wr, fr, P); }
    __device__ __forceinline__ void operator()(const f32x4 (&acc)[2][2][4][2], const Unit& u, int wr, int wc, int fr, int fq, const Pre& P) const {
        const int row0 = u.pm * BM + wr * 64 + fr; const int pn = u.pn;
        if (pn >= 14 && pn < 20) {
            const int isk = pn >= 17 ? 1 : 0; const int head = 4 * (pn - 14 - 3 * isk) + wc;
            bf16_t* dst = (bf16_t*)(ws + WS_AQ + (size_t)isk * (WS_AK - WS_AQ)); const float* gain = qgain + (kgain - qgain) * isk;
            const float post = isk ? 1.0f : 0.125f * 1.4426950408889634f;
            f32x4 gv[2][2];
#pragma unroll
            for (int bj = 0; bj < 2; ++bj)
#pragma unroll
                for (int n = 0; n < 2; ++n) gv[bj][n] = *(const f32x4*)(gain + bj * 32 + 8 * fq + 4 * n) * post;
#pragma unroll
            for (int ai = 0; ai < 2; ++ai)
#pragma unroll
                for (int m = 0; m < 4; ++m) {
                    const int row = row0 + ai * HALF + m * 16; const float s = scale_of(P.v[4 * ai + m]); float q = 0.f; f32x4 v[2][2];
#pragma unroll
                    for (int bj = 0; bj < 2; ++bj)
#pragma unroll
                        for (int n = 0; n < 2; ++n) { v[bj][n] = acc[ai][bj][m][n] * s; const f32x4 x = v[bj][n]; q += (x[0] * x[0] + x[1] * x[1]) + (x[2] * x[2] + x[3] * x[3]); }
                    q += __shfl_xor(q, 16); q += __shfl_xor(q, 32);
                    const float rn = __builtin_amdgcn_rsqf(q * (1.0f / 64.0f) + 1e-6f);
#pragma unroll
                    for (int bj = 0; bj < 2; ++bj) { const int cc = head * 64 + bj * 32 + 8 * fq; st16(dst + (isk ? hm12(row, cc) : (size_t)row * 768 + cc), pack8(v[bj][0] * rn * gv[bj][0], v[bj][1] * rn * gv[bj][1])); }
                }
            return;
        }
        size_t boff; int ld, colt, lim;
        if (pn < 12) { boff = WS_PR + (size_t)(pn >> 2) * (WS_PK - WS_PR); ld = 1024; colt = (pn & 3) * 256; lim = 1 << 30; }
        else if (pn < 14) { boff = WS_LORA; ld = 288; colt = (pn - 12) * 256; lim = 288; }
        else { boff = WS_AV; ld = 768; colt = (pn - 20) * 256; lim = 1 << 30; }
        bf16_t* dst = (bf16_t*)(ws + boff);
        const int col0 = colt + wc * 32 + 8 * fq;
#pragma unroll
        for (int ai = 0; ai < 2; ++ai)
#pragma unroll
            for (int m = 0; m < 4; ++m) {
                const int row = row0 + ai * HALF + m * 16; const float s = scale_of(P.v[4 * ai + m]);
#pragma unroll
                for (int bj = 0; bj < 2; ++bj) { const int c = col0 + bj * HALF; if (c < lim) st16(dst + (pn < 12 ? hmoff(row, c) : pn >= 20 ? hm12(row, c) : (size_t)row * ld + c), pack8(acc[ai][bj][m][0] * s, acc[ai][bj][m][1] * s)); }
            }
    }
};

__device__ __forceinline__ size_t goff(int pm, int pn8, int ai, int m, int bj, int wr, int wc, int fr, int fq) {
    return ((((size_t)(pm * 8 + pn8) * 16 + (ai * 8 + m * 2 + bj)) * 512) + ((wr * 4 + wc) * 64 + fq * 16 + fr)) * 8; }
struct EpiGates {
    static constexpr bool PERM = true, AFTER_DRAIN = false, TWICE_OK = true; static constexpr bool Z64 = true;
    typedef PreRows Pre;
    bf16_t* G; const float* ss; const float* bgate;
    __device__ __forceinline__ void pre(const Unit& u, int wr, int fr, Pre& P) const { load_rows_ss(ss, u, wr, fr, P); }
    __device__ __forceinline__ void operator()(const f32x4 (&acc)[2][2][4][2], const Unit& u, int wr, int wc, int fr, int fq, const Pre& P) const {
        const int row0 = u.pm * BM + wr * 64 + fr, col0 = u.pn * BM + wc * 32 + 8 * fq;
        f32x4 bv[2][2];
#pragma unroll
        for (int bj = 0; bj < 2; ++bj)
#pragma unroll
            for (int n = 0; n < 2; ++n) bv[bj][n] = *(const f32x4*)(bgate + col0 + bj * HALF + 4 * n) * -1.4426950408889634f;
#pragma unroll
        for (int ai = 0; ai < 2; ++ai)
#pragma unroll
            for (int m = 0; m < 4; ++m) {
                const int row = row0 + ai * HALF + m * 16; const float s = scale_of(P.v[4 * ai + m]) * -1.4426950408889634f;
#pragma unroll
                for (int bj = 0; bj < 2; ++bj) { f32x4 o[2];
#pragma unroll
                    for (int n = 0; n < 2; ++n)
#pragma unroll
                        for (int i = 0; i < 4; ++i) o[n][i] = __builtin_amdgcn_rcpf(1.0f + __builtin_amdgcn_exp2f(acc[ai][bj][m][n][i] * s + bv[bj][n][i]));
                    st16(G + goff(u.pm, u.pn, ai, m, bj, wr, wc, fr, fq), pack8(o[0], o[1])); }
            }
    }
};

struct EpiGn {
    static constexpr bool PERM = true, AFTER_DRAIN = false, TWICE_OK = false; static constexpr bool Z64 = false;
    typedef PreNone Pre;
    bf16_t* wkv; const bf16_t* pv; const float* bonus; const float* muv; const float* lnw; const float* lnb;
    __device__ __forceinline__ void pre(const Unit&, int, int, Pre&) const {}
    __device__ __forceinline__ void operator()(const f32x4 (&acc)[2][2][4][2], const Unit& u, int wr, int wc, int fr, int fq, const Pre&) const {
        const int row0 = u.pm * BM + wr * 64 + fr; const int head = 4 * u.pn + wc; const int cb = head * 64 + 8 * fq;
        f32x4 w_[2][2];
#pragma unroll
        for (int bj = 0; bj < 2; ++bj)
#pragma unroll
            for (int n = 0; n < 2; ++n) { const int c = cb + bj * 32 + 4 * n; w_[bj][n] = *(const f32x4*)(lnw + c); }
#pragma unroll
        for (int ai = 0; ai < 2; ++ai)
#pragma unroll
            for (int m = 0; m < 4; ++m) {
                int row = row0 + ai * HALF + m * 16; asm volatile("" : "+v"(row) :: "memory"); const bool hasprev = (row & 4095) != 0;
                f32x4 x[2][2]; float s1 = 0.f;
#pragma unroll
                for (int bj = 0; bj < 2; ++bj) {
                    unpack8(*(const u32x4*)(wkv + (size_t)row * 1024 + cb + bj * 32), x[bj][0], x[bj][1]);
#pragma unroll
                    for (int n = 0; n < 2; ++n) s1 += (x[bj][n][0] + x[bj][n][1]) + (x[bj][n][2] + x[bj][n][3]);
                }
                s1 += __shfl_xor(s1, 16); s1 += __shfl_xor(s1, 32);
                const float mean = s1 * (1.0f / 64.0f); float s2 = 0.f;
#pragma unroll
                for (int bj = 0; bj < 2; ++bj)
#pragma unroll
                    for (int n = 0; n < 2; ++n) { x[bj][n] = x[bj][n] - mean; const f32x4 d = x[bj][n]; s2 += (d[0] * d[0] + d[1] * d[1]) + (d[2] * d[2] + d[3] * d[3]); }
                s2 += __shfl_xor(s2, 16); s2 += __shfl_xor(s2, 32);
                const float rstd = __builtin_amdgcn_rsqf(s2 * (1.0f / 64.0f) + 64e-5f);
                const float bon = bonus[(size_t)row * 16 + head];
#pragma unroll
                for (int bj = 0; bj < 2; ++bj) {
                    const size_t off = (size_t)row * 1024 + cb + bj * 32; int cbo = cb + bj * 32; asm volatile("" : "+v"(cbo)); const size_t voff = hmoff(row, cbo);
                    f32x4 vc[2], vp[2]; unpack8(*(const u32x4*)(pv + voff), vc[0], vc[1]);
                    if (hasprev) unpack8(*(const u32x4*)(pv + voff - 64), vp[0], vp[1]); else { vp[0] = (f32x4){0.f, 0.f, 0.f, 0.f}; vp[1] = vp[0]; }
                    f32x4 o[2];
#pragma unroll
                    for (int n = 0; n < 2; ++n) { const int c = cb + bj * 32 + 4 * n;
                        const f32x4 b_ = *(const f32x4*)(lnb + c), mu_ = *(const f32x4*)(muv + c);
                        const f32x4 vs = vc[n] + (vp[n] - vc[n]) * mu_;
                        o[n] = (x[bj][n] * rstd * w_[bj][n] + b_ + vs * bon) * acc[ai][bj][m][n]; }
                    st16(wkv + off, pack8(o[0], o[1]));
                    asm volatile("" ::: "memory"); }
            }
    }
};

template <bool SECOND, int GH> struct EpiProj {
    static constexpr bool PERM = true, AFTER_DRAIN = false, TWICE_OK = !SECOND; static constexpr bool Z64 = true;
    typedef PreNone Pre;
    bf16_t* mg; const bf16_t* gates;
    __device__ __forceinline__ void pre(const Unit&, int, int, Pre&) const {}
    __device__ __forceinline__ void operator()(const f32x4 (&acc)[2][2][4][2], const Unit& u, int wr, int wc, int fr, int fq, const Pre&) const {
        const int row0 = u.pm * BM + wr * 64 + fr, col0 = u.pn * BM + wc * 32 + 8 * fq;
#pragma unroll
        for (int ai = 0; ai < 2; ++ai)
#pragma unroll
            for (int m = 0; m < 4; ++m) {
                const int row = row0 + ai * HALF + m * 16;
#pragma unroll
                for (int bj = 0; bj < 2; ++bj) {
                    f32x4 g0, g1; unpack8(*(const u32x4*)(gates + goff(u.pm, u.pn + 4 * GH, ai, m, bj, wr, wc, fr, fq)), g0, g1);
                    f32x4 o0 = g0 * acc[ai][bj][m][0], o1 = g1 * acc[ai][bj][m][1];
                    bf16_t* p = mg + boff(row, col0 + bj * HALF);
                    if (SECOND) { f32x4 t0, t1; unpack8(*(const u32x4*)p, t0, t1); o0 += t0; o1 += t1; }
                    st16(p, pack8(o0, o1));
                }
            }
    }
};
typedef double f64x2_ __attribute__((ext_vector_type(2)));
template <class Epi, class Sched, bool ALIGN_EPI = false, bool SP2 = false>
__device__ __forceinline__ void gemm_phase(PG8_LAS unsigned char* lds, const Gemm g, const Sched& S, const Epi& E) {
    int tid_ = threadIdx.x; asm volatile("" : "+v"(tid_));
    const int tid = tid_, wid = __builtin_amdgcn_readfirstlane(tid >> 6), lane = tid & 63, wr = wid >> 2, wc = wid & 3, fr = lane & 15, fq = lane >> 4;
    const int K = g.K, nt = K / BK;
#ifdef STATIC_PRIO
    if (wid >= 4) __builtin_amdgcn_s_setprio(1);
#endif
    unsigned voffA[2], voffB[2];
#pragma unroll
    for (int i = 0; i < 2; ++i) { int R, C; stage_rc(tid * 16 + i * 8192, R, C); const int Rb = Epi::PERM ? ((R & ~31) + perm32(R & 31)) : R;
        const int ldA = (g.blk & 1) ? BK : K, ldB = (g.blk & 2) ? BK : K;
        voffA[i] = (unsigned)(R * ldA + C) * 2u; voffB[i] = (unsigned)(Rb * ldB + C) * 2u; }
    const size_t kstepA = (g.blk & 1) ? (size_t)(BM * BK * 2) : (size_t)(BK * 2), kstepB = (g.blk & 2) ? (size_t)(BM * BK * 2) : (size_t)(BK * 2);
    const size_t hstepA = (g.blk & 1) ? (size_t)(HALF * BK * 2) : (size_t)HALF * K * 2, hstepB = (g.blk & 2) ? (size_t)(HALF * BK * 2) : (size_t)HALF * K * 2;
    const size_t tstep = (size_t)BM * K * 2;
    const unsigned ldsw = (unsigned)wid * 1024u;
    const int aoff = lds_byte(wr * 64 + fr, fq * 8), boff = lds_byte(wc * 32 + fr, fq * 8);
#define PG8_SA(b, h) (((b) * 2 + (h)) * HTB)
#define PG8_SB(b, h) ((4 + (b) * 2 + (h)) * HTB)
#define PG8_STAGE(bufoff, gbase, voff) do { _Pragma("unroll") for (int _i = 0; _i < 2; ++_i) \
        __builtin_amdgcn_global_load_lds((const unsigned*)((const char*)(gbase) + (voff)[_i]), (PG8_LAS unsigned*)(lds + (bufoff) + ldsw + _i * 8192), 16, 0, 0); } while (0)
#define PG8_LDA(dst, b, h) do { _Pragma("unroll") for (int m = 0; m < 4; ++m) _Pragma("unroll") for (int k = 0; k < 2; ++k) dst[m][k] = *(const PG8_LAS bf16x8*)(lds + PG8_SA(b, h) + aoff + m * 2048 + k * 1024); } while (0)
#define PG8_LDB(dst, b, h) do { _Pragma("unroll") for (int n = 0; n < 2; ++n) _Pragma("unroll") for (int k = 0; k < 2; ++k) dst[n][k] = *(const PG8_LAS bf16x8*)(lds + PG8_SB(b, h) + boff + n * 2048 + k * 1024); } while (0)
#ifdef STATIC_PRIO
#define PG8_PRIO1()
#define PG8_PRIO0()
#else
#define PG8_PRIO1() __builtin_amdgcn_s_setprio(1)
#define PG8_PRIO0() __builtin_amdgcn_s_setprio(0)
#endif
#define PG8_MMA(ai, bj, At, Bt) do { PG8_PRIO1(); _Pragma("unroll") for (int m = 0; m < 4; ++m) _Pragma("unroll") for (int n = 0; n < 2; ++n) _Pragma("unroll") for (int k = 0; k < 2; ++k) \
        acc[ai][bj][m][n] = __builtin_amdgcn_mfma_f32_16x16x32_bf16(Bt[n][k], At[m][k], acc[ai][bj][m][n], 0, 0, 0); PG8_PRIO0(); } while (0)
#define PG8_MMA_Z(ai, bj, At, Bt) do { PG8_PRIO1(); _Pragma("unroll") for (int m = 0; m < 4; ++m) _Pragma("unroll") for (int n = 0; n < 2; ++n) { \
        acc[ai][bj][m][n] = __builtin_amdgcn_mfma_f32_16x16x32_bf16(Bt[n][0], At[m][0], (f32x4){0.f, 0.f, 0.f, 0.f}, 0, 0, 0); \
        acc[ai][bj][m][n] = __builtin_amdgcn_mfma_f32_16x16x32_bf16(Bt[n][1], At[m][1], acc[ai][bj][m][n], 0, 0, 0); } PG8_PRIO0(); } while (0)
#define PG8_WAIT_V(n) asm volatile("s_waitcnt vmcnt(" #n ")" ::: "memory")
#define PG8_WAIT_L(n) asm volatile("s_waitcnt lgkmcnt(" #n ")" ::: "memory")
#define PG8_BAR __builtin_amdgcn_s_barrier()
#define PG8_SCHED __builtin_amdgcn_sched_barrier(0)
    Unit cur, nxt; int ui = 0;
    if (!S.next(0, cur)) return;
    f32x4 acc[2][2][4][2];
#ifndef ZERO_C
#pragma unroll
    for (int a = 0; a < 2; ++a)
#pragma unroll
        for (int b = 0; b < 2; ++b)
#pragma unroll
            for (int m = 0; m < 4; ++m)
#pragma unroll
                for (int n = 0; n < 2; ++n) { if constexpr (Epi::Z64) { double z0_, z1_; asm volatile("v_mov_b64 %0, 0" : "=v"(z0_)); asm volatile("v_mov_b64 %0, 0" : "=v"(z1_)); acc[a][b][m][n] = __builtin_bit_cast(f32x4, ((f64x2_){z0_, z1_})); } else acc[a][b][m][n] = (f32x4){0.f, 0.f, 0.f, 0.f}; }
#endif
    bf16x8 At[4][2], B0[2][2], B1[2][2];
    const char* cA = (const char*)g.A + (size_t)cur.pm * tstep; const char* cB = (const char*)g.Bt + (size_t)cur.pn * tstep;
    S.a_ready(cur);
    typename Epi::Pre pre_; E.pre(cur, wr, fr, pre_);
    if constexpr (SP2) {
        PG8_STAGE(PG8_SB(0, 0), cB, voffB); PG8_STAGE(PG8_SB(0, 1), cB + hstepB, voffB); PG8_STAGE(PG8_SA(0, 0), cA, voffA); PG8_STAGE(PG8_SA(0, 1), cA + hstepA, voffA);
        if (wr == 1) PG8_BAR;
        PG8_WAIT_V(2); PG8_BAR;
        PG8_STAGE(PG8_SB(1, 0), cB + kstepB, voffB); PG8_STAGE(PG8_SA(1, 0), cA + kstepA, voffA); PG8_STAGE(PG8_SB(1, 1), cB + hstepB + kstepB, voffB);
        PG8_WAIT_V(6); PG8_BAR;
    } else {
        PG8_STAGE(PG8_SB(0, 0), cB, voffB); PG8_STAGE(PG8_SA(0, 0), cA, voffA); PG8_STAGE(PG8_SB(0, 1), cB + hstepB, voffB); PG8_STAGE(PG8_SA(0, 1), cA + hstepA, voffA);
        if (wr == 1) PG8_BAR;
        PG8_WAIT_V(4); PG8_BAR;
        PG8_STAGE(PG8_SB(1, 0), cB + kstepB, voffB); PG8_STAGE(PG8_SA(1, 0), cA + kstepA, voffA); PG8_STAGE(PG8_SB(1, 1), cB + hstepB + kstepB, voffB);
        PG8_WAIT_V(6); PG8_BAR;
    }
    for (;;) {
        const bool has_next = S.next(ui + 1, nxt);
        const char* nA = has_next ? (const char*)g.A + (size_t)nxt.pm * tstep : cA; const char* nB = has_next ? (const char*)g.Bt + (size_t)nxt.pn * tstep : cB;
#ifdef ZERO_C
        if constexpr (SP2) {
            const int t = 0; const bool last = (nt == 2);
            const char* a1 = cA + (size_t)(t + 1) * kstepA;
            const char* a2 = last ? nA : cA + (size_t)(t + 2) * kstepA; const char* b2 = last ? nB : cB + (size_t)(t + 2) * kstepB;
            const char* a3 = a2 + kstepA; const char* b3 = b2 + kstepB;
            if (last && has_next) S.a_ready(nxt);
            PG8_LDB(B0, 0, 0); PG8_LDB(B1, 0, 1); PG8_SCHED; PG8_LDA(At, 0, 0); PG8_STAGE(PG8_SA(1, 1), a1 + hstepA, voffA);
            PG8_WAIT_V(8); PG8_WAIT_L(0); PG8_BAR; PG8_MMA_Z(0, 0, At, B0); PG8_MMA_Z(0, 1, At, B1); PG8_BAR; PG8_SCHED;
            PG8_LDA(At, 0, 1); PG8_STAGE(PG8_SB(0, 0), b2, voffB); PG8_STAGE(PG8_SB(0, 1), b2 + hstepB, voffB); PG8_STAGE(PG8_SA(0, 0), a2, voffA);
            PG8_WAIT_V(8); PG8_WAIT_L(0); PG8_BAR; PG8_MMA_Z(1, 0, At, B0); PG8_MMA_Z(1, 1, At, B1); PG8_BAR; PG8_SCHED;
            PG8_LDB(B0, 1, 0); PG8_LDB(B1, 1, 1); PG8_SCHED; PG8_LDA(At, 1, 0); PG8_STAGE(PG8_SA(0, 1), a2 + hstepA, voffA);
            PG8_WAIT_V(8); PG8_WAIT_L(0); PG8_BAR; PG8_MMA(0, 0, At, B0); PG8_MMA(0, 1, At, B1); PG8_BAR; PG8_SCHED;
            PG8_LDA(At, 1, 1); PG8_STAGE(PG8_SB(1, 0), b3, voffB); PG8_STAGE(PG8_SB(1, 1), b3 + hstepB, voffB); PG8_STAGE(PG8_SA(1, 0), a3, voffA);
            PG8_WAIT_V(8); PG8_WAIT_L(0); PG8_BAR; PG8_MMA(1, 0, At, B0); PG8_MMA(1, 1, At, B1); PG8_BAR; PG8_SCHED;
        }
        for (int t = (SP2 ? 2 : 0); t < nt; t += 2) {
#else
        for (int t = 0; t < nt; t += 2) {
#endif
            const bool last = (t == nt - 2);
            const char* a1 = cA + (size_t)(t + 1) * kstepA;
            const char* a2 = last ? nA : cA + (size_t)(t + 2) * kstepA; const char* b2 = last ? nB : cB + (size_t)(t + 2) * kstepB;
            const char* a3 = a2 + kstepA; const char* b3 = b2 + kstepB;
            if (last && has_next) S.a_ready(nxt);
            if constexpr (SP2) {
            PG8_LDB(B0, 0, 0); PG8_LDB(B1, 0, 1); PG8_SCHED; PG8_LDA(At, 0, 0); PG8_STAGE(PG8_SA(1, 1), a1 + hstepA, voffA);
            PG8_WAIT_V(8); PG8_WAIT_L(0); PG8_BAR; PG8_MMA(0, 0, At, B0); PG8_MMA(0, 1, At, B1); PG8_BAR; PG8_SCHED;
            PG8_LDA(At, 0, 1); PG8_STAGE(PG8_SB(0, 0), b2, voffB); PG8_STAGE(PG8_SB(0, 1), b2 + hstepB, voffB); PG8_STAGE(PG8_SA(0, 0), a2, voffA);
            PG8_WAIT_V(8); PG8_WAIT_L(0); PG8_BAR; PG8_MMA(1, 0, At, B0); PG8_MMA(1, 1, At, B1); PG8_BAR; PG8_SCHED;
            PG8_LDB(B0, 1, 0); PG8_LDB(B1, 1, 1); PG8_SCHED; PG8_LDA(At, 1, 0); PG8_STAGE(PG8_SA(0, 1), a2 + hstepA, voffA);
            PG8_WAIT_V(8); PG8_WAIT_L(0); PG8_BAR; PG8_MMA(0, 0, At, B0); PG8_MMA(0, 1, At, B1); PG8_BAR; PG8_SCHED;
            PG8_LDA(At, 1, 1); PG8_STAGE(PG8_SB(1, 0), b3, voffB); PG8_STAGE(PG8_SB(1, 1), b3 + hstepB, voffB); PG8_STAGE(PG8_SA(1, 0), a3, voffA);
            PG8_WAIT_V(8); PG8_WAIT_L(0); PG8_BAR; PG8_MMA(1, 0, At, B0); PG8_MMA(1, 1, At, B1); PG8_BAR; PG8_SCHED;
            } else {
            PG8_LDB(B0, 0, 0); PG8_SCHED; PG8_LDA(At, 0, 0); PG8_STAGE(PG8_SA(1, 1), a1 + hstepA, voffA);
            PG8_WAIT_L(8); PG8_BAR; PG8_WAIT_L(0); PG8_MMA(0, 0, At, B0); PG8_BAR; PG8_SCHED;
            PG8_LDB(B1, 0, 1); PG8_STAGE(PG8_SB(0, 0), b2, voffB);
            PG8_BAR; PG8_WAIT_L(0); PG8_MMA(0, 1, At, B1); PG8_BAR;
            PG8_LDA(At, 0, 1); PG8_STAGE(PG8_SA(0, 0), a2, voffA);
            PG8_BAR; PG8_WAIT_L(0); PG8_MMA(1, 0, At, B0); PG8_BAR; PG8_SCHED;
            PG8_STAGE(PG8_SB(0, 1), b2 + hstepB, voffB);
            PG8_WAIT_V(6); PG8_BAR; PG8_MMA(1, 1, At, B1); PG8_BAR;
            PG8_LDB(B0, 1, 0); PG8_SCHED; PG8_LDA(At, 1, 0); PG8_STAGE(PG8_SA(0, 1), a2 + hstepA, voffA);
            PG8_WAIT_L(8); PG8_BAR; PG8_WAIT_L(0); PG8_MMA(0, 0, At, B0); PG8_BAR; PG8_SCHED;
            PG8_LDB(B1, 1, 1); PG8_STAGE(PG8_SB(1, 0), b3, voffB);
            PG8_BAR; PG8_WAIT_L(0); PG8_MMA(0, 1, At, B1); PG8_BAR;
            PG8_LDA(At, 1, 1); PG8_STAGE(PG8_SA(1, 0), a3, voffA);
            PG8_BAR; PG8_WAIT_L(0); PG8_MMA(1, 0, At, B0); PG8_BAR; PG8_SCHED;
            PG8_STAGE(PG8_SB(1, 1), b3 + hstepB, voffB);
            PG8_WAIT_V(6); PG8_BAR; PG8_MMA(1, 1, At, B1); PG8_BAR;
            }
        }
        if constexpr (ALIGN_EPI) { if (wr == 0) PG8_BAR; }
        if constexpr (!Epi::AFTER_DRAIN) { E(acc, cur, wr, wc, fr, fq, pre_);
#ifdef EPI_TWICE
            if constexpr (Epi::TWICE_OK) { asm volatile("" ::: "memory"); E(acc, cur, wr, wc, fr, fq, pre_); }
#endif
            S.done(cur); }
        if (!has_next) break;
#ifndef ZERO_C
#pragma unroll
        for (int a = 0; a < 2; ++a)
#pragma unroll
            for (int b = 0; b < 2; ++b)
#pragma unroll
                for (int m = 0; m < 4; ++m)
#pragma unroll
                    for (int n = 0; n < 2; ++n) { if constexpr (Epi::Z64) { double z0_, z1_; asm volatile("v_mov_b64 %0, 0" : "=v"(z0_)); asm volatile("v_mov_b64 %0, 0" : "=v"(z1_)); acc[a][b][m][n] = __builtin_bit_cast(f32x4, ((f64x2_){z0_, z1_})); } else acc[a][b][m][n] = (f32x4){0.f, 0.f, 0.f, 0.f}; }
#endif
        cur = nxt; cA = nA; cB = nB; ++ui; E.pre(cur, wr, fr, pre_);
        if constexpr (ALIGN_EPI) { if (wr == 1) PG8_BAR; }
    }
#ifdef STATIC_PRIO
    __builtin_amdgcn_s_setprio(0);
#endif
    PG8_WAIT_V(0);
    if constexpr (!ALIGN_EPI) { if (wr == 0) PG8_BAR; }
    PG8_BAR;
    if constexpr (Epi::AFTER_DRAIN) { E.fused(acc, cur, wr, wc, fr, fq, lds, wid, lane); S.done(cur); }
#undef PG8_SA
#undef PG8_SB
#undef PG8_STAGE
#undef PG8_LDA
#undef PG8_LDB
#undef PG8_MMA
#undef PG8_MMA_Z
#undef PG8_WAIT_V
#undef PG8_WAIT_L
#undef PG8_BAR
#undef PG8_SCHED
}
}
#define GAS __attribute__((address_space(1)))
#define LAS __attribute__((address_space(3)))
typedef unsigned short bf16;
typedef unsigned v4u __attribute__((ext_vector_type(4)));
typedef float f32x4 __attribute__((ext_vector_type(4)));
typedef short bf16x8 __attribute__((ext_vector_type(8)));
typedef GAS unsigned gu32;
typedef GAS unsigned long long gu64;
#define RLX_AGENT __ATOMIC_RELAXED, __HIP_MEMORY_SCOPE_AGENT
#define LDS_WAIT() asm volatile("s_waitcnt lgkmcnt(0)" ::: "memory")
#define VM_WAIT() asm volatile("s_waitcnt vmcnt(0)" ::: "memory")
__device__ __forceinline__ unsigned long long rt() { return __builtin_amdgcn_s_memrealtime(); }
__device__ __forceinline__ unsigned f2bf(float f) { unsigned u = __builtin_bit_cast(unsigned, f); return (u + 0x7fffu + ((u >> 16) & 1u)) >> 16; }
__device__ __forceinline__ unsigned pk2(float lo, float hi) { return f2bf(lo) | (f2bf(hi) << 16); }
#define XB_TMO      128
#define XB_XCNT(j)  (256  + 64 * (j))
#define XB_XSUB(j)  (1280 + 64 * (j))
#define XB_XGEN(j)  (2304 + 64 * (j))
#define XB_TOP      3328
#define XB_TOPGEN   3392
#define XCD_BAR_WORDS 3456
#define XB_SPIN_CAP (1u << 18)

__device__ __forceinline__ unsigned xb_ld(unsigned* p)              { return __hip_atomic_load(p, __ATOMIC_RELAXED, __HIP_MEMORY_SCOPE_AGENT); }
__device__ __forceinline__ unsigned xb_add(unsigned* p, unsigned v) { return __hip_atomic_fetch_add(p, v, __ATOMIC_RELAXED, __HIP_MEMORY_SCOPE_AGENT); }
__device__ __forceinline__ unsigned xb_xcc_id() { return (unsigned)__builtin_amdgcn_s_getreg((3 << 11) | 20) & 0xFu; }
#define XB_SPIN(cond, bar) do { unsigned _sp = 0; while (cond) { __builtin_amdgcn_s_sleep(1); \
    if ((++_sp & 255u) == 0u) { if (xb_ld(&(bar)[XB_TMO])) break; if (_sp > XB_SPIN_CAP) { atomicAdd(&(bar)[XB_TMO], 1u); break; } } } } while (0)

struct XcdBarrier {
    unsigned* bar; unsigned x;
    volatile LAS unsigned* st;
};

__device__ __forceinline__ XcdBarrier xcd_barrier_post(unsigned* bar, volatile LAS unsigned* st) {
    XcdBarrier b; b.bar = bar; b.x = xb_xcc_id(); b.st = st;
    if (threadIdx.x == 0) (void)xb_add(&bar[XB_XCNT(b.x)], 1u);
    return b;
}
__device__ __forceinline__ void xcd_barrier_complete(unsigned* bar, unsigned x, unsigned& nloc, unsigned& nx) {
    const unsigned G = gridDim.x * gridDim.y * gridDim.z;
    unsigned sum, cnt, mine, sp = 0u;
    for (;;) {
        sum = 0u; cnt = 0u; mine = 0u;
#pragma unroll
        for (unsigned j = 0; j < 16; ++j) { const unsigned c = xb_ld(&bar[XB_XCNT(j)]); sum += c; cnt += (c > 0u) ? 1u : 0u; mine = (j == x) ? c : mine; }
        if (sum == G) break;
        __builtin_amdgcn_s_sleep(1);
        if ((++sp & 255u) == 0u) { if (xb_ld(&bar[XB_TMO])) break; if (sp > XB_SPIN_CAP) { atomicAdd(&bar[XB_TMO], 1u); break; } }
    }
    nloc = mine > 0u ? mine : 1u; nx = cnt > 0u ? cnt : 1u;
}

__device__ __forceinline__ void xcd_barrier(const XcdBarrier& b) {
    asm volatile("s_waitcnt vmcnt(0)" ::: "memory");
    __syncthreads();
    if (threadIdx.x == 0) {
        unsigned* bar = b.bar;
        __builtin_amdgcn_s_waitcnt(0);
        unsigned nloc = b.st[0], nx = b.st[1];
        if (nloc == 0u) { xcd_barrier_complete(bar, b.x, nloc, nx); b.st[0] = nloc; b.st[1] = nx; }
        const unsigned old = xb_add(&bar[XB_XSUB(b.x)], 1u);
        const unsigned gen = old / nloc;
        if (old + 1u == (gen + 1u) * nloc) {
            __builtin_amdgcn_fence(__ATOMIC_RELEASE, "agent");
            asm volatile("s_waitcnt vmcnt(0)" ::: "memory");
            const unsigned og = xb_add(&bar[XB_TOP], 1u);
            const unsigned tg = og / nx;
            if (og + 1u == (tg + 1u) * nx) xb_add(&bar[XB_TOPGEN], 1u);
            else XB_SPIN(xb_ld(&bar[XB_TOPGEN]) == tg, bar);
            __builtin_amdgcn_fence(__ATOMIC_ACQUIRE, "agent");
            xb_add(&bar[XB_XGEN(b.x)], 1u);
            asm volatile("s_waitcnt vmcnt(0)" ::: "memory");
        } else {
            XB_SPIN(xb_ld(&bar[XB_XGEN(b.x)]) == gen, bar);
            __builtin_amdgcn_fence(__ATOMIC_ACQUIRE, "agent");
            asm volatile("s_waitcnt vmcnt(0)" ::: "memory");
        }
    }
    __syncthreads();
}
struct Frame {
    LAS unsigned char* lds;
    volatile LAS unsigned* MISC;
    gu32* ctl;
    int tid, lane, wave;
    int vcu, G;
};
__device__ __forceinline__ float wave_sum(float v) {
#pragma unroll
    for (int o = 1; o < 64; o <<= 1) v += __shfl_xor(v, o);
    return v;
}
__device__ __forceinline__ float bf_lo(unsigned w) { return __uint_as_float(w << 16); }
__device__ __forceinline__ float bf_hi(unsigned w) { return __uint_as_float(w & 0xffff0000u); }
__device__ __forceinline__ float fsigmoid(float x) { return __builtin_amdgcn_rcpf(1.0f + __expf(-x)); }

__device__ __forceinline__ void p0_item(const float* W, int Ksrc, int Nsrc, int scol, const float* gain, bf16* WT, int Kd, int drow, int k0, LAS float* scr, int lane, bool blk = false, float mul = 1.0f) {
    float v[32];
    const bool ok = scol >= 0;
    const float* src = W + (size_t)(k0 + (lane >> 5)) * Nsrc + (ok ? scol : 0) + (lane & 31);
#pragma unroll
    for (int i = 0; i < 32; ++i) { const int kg = k0 + 2 * i + (lane >> 5); v[i] = (ok && kg < Ksrc) ? src[(size_t)(2 * i) * Nsrc] : 0.f; }
#pragma unroll
    for (int i = 0; i < 32; ++i) scr[(2 * i + (lane >> 5)) * 33 + (lane & 31)] = v[i];
    LDS_WAIT(); asm volatile("" ::: "memory");
    const int c = lane & 7;
    f32x4 g0 = (f32x4){1.f, 1.f, 1.f, 1.f}, g1 = g0;
    if (gain) { g0 = *(const f32x4*)(gain + k0 + 8 * c); g1 = *(const f32x4*)(gain + k0 + 8 * c + 4); }
    g0 *= mul; g1 *= mul;
#pragma unroll
    for (int j = 0; j < 4; ++j) { const int n = (lane >> 3) + 8 * j; const LAS float* s = scr + (8 * c) * 33 + n;
        v4u o; o.x = pk2(s[0 * 33] * g0[0], s[1 * 33] * g0[1]); o.y = pk2(s[2 * 33] * g0[2], s[3 * 33] * g0[3]); o.z = pk2(s[4 * 33] * g1[0], s[5 * 33] * g1[1]); o.w = pk2(s[6 * 33] * g1[2], s[7 * 33] * g1[3]);
        const int dr = drow + n;
        bf16* dst = blk ? WT + (size_t)(dr >> 8) * ((size_t)256 * Kd) + (size_t)(k0 >> 6) * (256 * 64) + (dr & 255) * 64 + 8 * c
                        : WT + (size_t)dr * Kd + k0 + 8 * c;
        *(GAS v4u*)dst = o; }
    LDS_WAIT(); asm volatile("" ::: "memory");
}
__device__ __forceinline__ int map_ffn_in(int db) { const int n = 32 * db, pn = n >> 8, bj = (n >> 7) & 1, jj = n & 127; return bj * FF + 128 * pn + jj; }
__device__ __forceinline__ int map_mix(int db) {
    const int pn = db >> 3, w = db & 7, bj = w >> 2, wc = w & 3;
    if (pn < 12) return 256 * pn + 32 * w;
    if (pn < 14) { const int c = (pn - 12) * 256 + 32 * w; return c < 288 ? 3072 + c : -1; }
    if (pn < 20) { const int isk = (pn - 14) / 3, tt = (pn - 14) % 3; return RW_COLS + isk * AW + (4 * tt + wc) * 64 + bj * 32; }
    return RW_COLS + 2 * AW + (pn - 20) * 256 + 32 * w;
}
__device__ __forceinline__ int map_g2(int db) { const int pn = db >> 3, w = db & 7, bj = w >> 2, wc = w & 3; return (4 * pn + wc) * 64 + bj * 32; }

struct P0Args { const float* in[26]; unsigned char* ws; float* out; };
__device__ __forceinline__ void p0_prologue(Frame& F, const P0Args& A, int part, int gw, int NGW) {
    LAS float* scr = (LAS float*)(F.lds + RING_OFF + F.wave * 16384);
    unsigned char* ws = A.ws;
    constexpr int J_W1 = 176 * 16, J_W2 = 32 * 44, J_WIN = 184 * 16, J_WG = 64 * 16, J_WA = 32 * 16, J_WB = 32 * 12, J_WO = 32 * 16, J_G2 = 32 * 4, J_L2 = 32 * 1;
    if (part == 1) {
        for (int it = gw; it < J_W1 + J_W2; it += NGW) {
            int r = it;
            if (r < J_W1) { const int db = r % 176, kb = r / 176; p0_item(A.in[24], D, 2 * FF, map_ffn_in(db), A.in[23], (bf16*)(ws + WS_W3T), D, 32 * db, 64 * kb, scr, F.lane, true); continue; } r -= J_W1;
            { const int db = r % 32, kb = r / 32; p0_item(A.in[25], FF, D, 32 * db, nullptr, (bf16*)(ws + WS_W4T), FF, 32 * db, 64 * kb, scr, F.lane, true); }
        }
        return;
    }
    constexpr int NITEMS = J_W1 + J_W2 + J_WIN + J_WG + J_WA + J_WB + J_WO + J_G2 + 2 * J_L2;
    for (int it = gw; it < NITEMS; it += NGW) {
        int r = it;
        if (r < J_W1) { const int db = r % 176, kb = r / 176; p0_item(A.in[2], D, 2 * FF, map_ffn_in(db), A.in[1], (bf16*)(ws + WS_W1T), D, 32 * db, 64 * kb, scr, F.lane, true); continue; } r -= J_W1;
        if (r < J_W2) { const int db = r % 32, kb = r / 32; p0_item(A.in[3], FF, D, 32 * db, nullptr, (bf16*)(ws + WS_W2T), FF, 32 * db, 64 * kb, scr, F.lane, true); continue; } r -= J_W2;
        if (r < J_WIN) { const int db = r % 184, kb = r / 184; p0_item(A.in[5], D, IN_COLS, map_mix(db), A.in[4], (bf16*)(ws + WS_WIN), D, 32 * db, 64 * kb, scr, F.lane, true); continue; } r -= J_WIN;
        if (r < J_WG) { const int db = r % 64, kb = r / 64; p0_item(A.in[5], D, IN_COLS, RW_COLS + 3 * AW + 32 * db, A.in[4], (bf16*)(ws + WS_WG), D, 32 * db, 64 * kb, scr, F.lane, true); continue; } r -= J_WG;
        if (r < J_WA) { const int db = r % 32, kb = r / 32; p0_item(A.in[20], D, D, 32 * db, nullptr, (bf16*)(ws + WS_WA), D, 32 * db, 64 * kb, scr, F.lane, true); continue; } r -= J_WA;
        if (r < J_WB) { const int db = r % 32, kb = r / 32; p0_item(A.in[21], AW, D, 32 * db, nullptr, (bf16*)(ws + WS_WB), AW, 32 * db, 64 * kb, scr, F.lane, true); continue; } r -= J_WB;
        if (r < J_WO) { const int db = r % 32, kb = r / 32; p0_item(A.in[22], D, D, 32 * db, nullptr, (bf16*)(ws + WS_WO), D, 32 * db, 64 * kb, scr, F.lane, true); continue; } r -= J_WO;
        if (r < J_G2) { const int db = r % 32, kb = r / 32; p0_item(A.in[12], 160, D, map_g2(db), nullptr, (bf16*)(ws + WS_G2T), 256, 32 * db, 64 * kb, scr, F.lane, true); continue; } r -= J_G2;
        if (r < J_L2) { p0_item(A.in[9], 64, D, 32 * r, nullptr, (bf16*)(ws + WS_L2T), 64, 32 * r, 0, scr, F.lane, false, -1.4426950408889634f); continue; }     r -= J_L2;
        p0_item(A.in[11], 64, D, 32 * r, nullptr, (bf16*)(ws + WS_L2T + 131072), 64, 32 * r, 0, scr, F.lane, false, -1.4426950408889634f);
    }
    bf16* xb0 = (bf16*)A.out; float* ss0 = (float*)(ws + WS_SS0); const float* x = A.in[0];
    for (int m = gw; m < M; m += NGW) {
        const GAS f32x4* xr = (const GAS f32x4*)(x + (size_t)m * D) + F.lane;
        f32x4 v[4]; float s = 0.f;
#pragma unroll
        for (int j = 0; j < 4; ++j) { v[j] = xr[64 * j]; s += (v[j].x * v[j].x + v[j].y * v[j].y) + (v[j].z * v[j].z + v[j].w * v[j].w); }
        s = wave_sum(s);
        GAS unsigned long long* o8 = (GAS unsigned long long*)(xb0 + (size_t)(m >> 8) * (256 * D) + (size_t)(F.lane >> 4) * (256 * 64) + (m & 255) * 64 + 4 * (F.lane & 15));
#pragma unroll
        for (int j = 0; j < 4; ++j) o8[(size_t)j * (4 * 256 * 64 / 4)] = (unsigned long long)pk2(v[j].x, v[j].y) | ((unsigned long long)pk2(v[j].z, v[j].w) << 32);
        if (F.lane == 0) { ss0[m] = s; ((float*)(ws + WS_SS1))[m] = 0.f; ((float*)(ws + WS_SS2))[m] = 0.f; }
    }
}

typedef short v4i16_t __attribute__((ext_vector_type(4)));
typedef unsigned v2u __attribute__((ext_vector_type(2)));
__device__ __forceinline__ bf16x8 vtr2(const LAS unsigned char* p0, const LAS unsigned char* p1) {
    const v4i16_t a = __builtin_amdgcn_ds_read_tr16_b64_v4i16((LAS v4i16_t*)p0), b = __builtin_amdgcn_ds_read_tr16_b64_v4i16((LAS v4i16_t*)p1);
    return (bf16x8){a[0], a[1], a[2], a[3], b[0], b[1], b[2], b[3]};
}
constexpr int ATT_LDK = 144;
constexpr int ATT_V_OFF = 256 * ATT_LDK;
struct AttnRegs { v4u kv[4], vv[4]; bf16x8 qf0, qf1; };
#define ATT_DECODE(unit) const int b = (unit) / 384, rem = (unit) % 384, head = rem >> 5, idx = rem & 31; const int dsh = 2 * (head >> 2); const int nbs = 5 - dsh; const int c = idx >> nbs, n = idx & ((1 << nbs) - 1);
__device__ __forceinline__ void attn_load(Frame& F, int unit, const bf16* AQ, const bf16* AK, const bf16* AV, AttnRegs& R, int tid_, int lane_) {
    ATT_DECODE(unit)
    const int row = tid_ >> 1, hf = tid_ & 1; const int sp = (n - 1) * 128 + row;
    if (sp >= 0) {
        const size_t off = ((size_t)(b * NHA + head) * SEQ + ((size_t)sp << dsh) + c) * 64 + hf * 32;
        const GAS v4u* kp = (const GAS v4u*)(AK + off); const GAS v4u* vp = (const GAS v4u*)(AV + off);
#pragma unroll
        for (int i = 0; i < 4; ++i) { R.kv[i] = kp[i]; R.vv[i] = vp[i]; }
    } else {
#pragma unroll
        for (int i = 0; i < 4; ++i) { R.kv[i] = (v4u){0u, 0u, 0u, 0u}; R.vv[i] = R.kv[i]; }
    }
    const int l15 = lane_ & 15, gq = lane_ >> 4; const int qi = 16 * F.wave + l15; const size_t qtok = (size_t)b * SEQ + ((size_t)(n * 128 + qi) << dsh) + c;
    R.qf0 = *(const GAS bf16x8*)(AQ + qtok * AW + head * 64 + 8 * gq); R.qf1 = *(const GAS bf16x8*)(AQ + qtok * AW + head * 64 + 32 + 8 * gq);
}
__device__ __forceinline__ void attn_phase(Frame& F, int first, int step, int nunits, const bf16* AQ, const bf16* AK, const bf16* AV, bf16* O, float* LSE, bool do_store) {
    LAS unsigned char* Kl = F.lds + RING_OFF; LAS unsigned char* Vl = Kl + ATT_V_OFF;
    const int w = F.wave;
    if (first >= nunits) return;
    AttnRegs R; attn_load(F, first, AQ, AK, AV, R, F.tid, F.lane);
    for (int unit = first; unit < nunits; unit += step) {
        int tid = F.tid; asm volatile("" : "+v"(tid)); const int lane = tid & 63, l15 = lane & 15, gq = lane >> 4;
        ATT_DECODE(unit)
        { const int row = tid >> 1, hf = tid & 1;
#pragma unroll
          for (int i = 0; i < 4; ++i) { *(LAS v4u*)(Kl + row * ATT_LDK + hf * 64 + i * 16) = R.kv[i]; *(LAS v4u*)(Vl + row * ATT_LDK + hf * 64 + i * 16) = R.vv[i]; } }
        const bf16x8 qf0 = R.qf0, qf1 = R.qf1;
        const int qi = 16 * w + l15; const size_t qtok = (size_t)b * SEQ + ((size_t)(n * 128 + qi) << dsh) + c;
        __syncthreads();
        if (unit + step < nunits) attn_load(F, unit + step, AQ, AK, AV, R, tid, lane);
        f32x4 S[9];
#pragma unroll
        for (int kt = 0; kt < 9; ++kt) {
            const LAS unsigned char* kr = Kl + (16 * (w + kt) + l15) * ATT_LDK + 16 * gq;
            const bf16x8 k0 = *(const LAS bf16x8*)kr, k1 = *(const LAS bf16x8*)(kr + 64);
            f32x4 a = (f32x4){0.f, 0.f, 0.f, 0.f};
            a = __builtin_amdgcn_mfma_f32_16x16x32_bf16(k0, qf0, a, 0, 0, 0);
            a = __builtin_amdgcn_mfma_f32_16x16x32_bf16(k1, qf1, a, 0, 0, 0);
            S[kt] = a;
        }
        float mx = -1e30f;
#pragma unroll
        for (int kt = 0; kt < 9; ++kt)
#pragma unroll
            for (int r = 0; r < 4; ++r) { const int j = 16 * (w + kt) + 4 * gq + r; const int dist = qi + 128 - j;
                const bool ok = dist >= 0 && dist <= 128 && (n > 0 || j >= 128);
                S[kt][r] = ok ? S[kt][r] : -1e30f; mx = fmaxf(mx, S[kt][r]); }
        mx = fmaxf(mx, __shfl_xor(mx, 16)); mx = fmaxf(mx, __shfl_xor(mx, 32));
        float den = 0.f;
#pragma unroll
        for (int kt = 0; kt < 9; ++kt)
#pragma unroll
            for (int r = 0; r < 4; ++r) { const float p = __builtin_amdgcn_exp2f(S[kt][r] - mx); S[kt][r] = p; den += p; }
        den += __shfl_xor(den, 16); den += __shfl_xor(den, 32);
        f32x4 Oa[4];
#pragma unroll
        for (int et = 0; et < 4; ++et) Oa[et] = (f32x4){0.f, 0.f, 0.f, 0.f};
        const int q4 = l15 >> 2, p4 = l15 & 3;
#pragma unroll
        for (int pp = 0; pp < 5; ++pp) {
            const int kt0 = 2 * pp, kt1 = (pp < 4) ? 2 * pp + 1 : 8;
            const f32x4 Pa = S[kt0]; const f32x4 Pb = (pp < 4) ? S[kt1] : (f32x4){0.f, 0.f, 0.f, 0.f};
            v4u pw; pw.x = pg8::cvt_pk_bf16(Pa[0], Pa[1]); pw.y = pg8::cvt_pk_bf16(Pa[2], Pa[3]); pw.z = pg8::cvt_pk_bf16(Pb[0], Pb[1]); pw.w = pg8::cvt_pk_bf16(Pb[2], Pb[3]);
            const bf16x8 pb = __builtin_bit_cast(bf16x8, pw);
            const LAS unsigned char* v0 = Vl + (16 * (w + kt0) + 4 * gq + q4) * ATT_LDK + 8 * p4;
            const LAS unsigned char* v1 = Vl + (16 * (w + kt1) + 4 * gq + q4) * ATT_LDK + 8 * p4;
#pragma unroll
            for (int et = 0; et < 4; ++et) { const bf16x8 va = vtr2(v0 + 32 * et, v1 + 32 * et); Oa[et] = __builtin_amdgcn_mfma_f32_16x16x32_bf16(va, pb, Oa[et], 0, 0, 0); }
        }
        const float inv = 1.0f / den;
        bf16* op = O + qtok * AW + head * 64 + 4 * gq;
#pragma unroll
        for (int et = 0; et < 4; ++et) { const f32x4 o = Oa[et] * inv; unsigned long long w2 = (unsigned long long)pg8::cvt_pk_bf16(o[0], o[1]) | ((unsigned long long)pg8::cvt_pk_bf16(o[2], o[3]) << 32);
            if (do_store) *(GAS unsigned long long*)(op + 16 * et) = w2; else asm volatile("" :: "v"(w2)); }
        if (gq == 0 && do_store) LSE[qtok * NHA + head] = mx + __builtin_amdgcn_logf(den);
        __syncthreads();
    }
}

typedef float f32x2v __attribute__((ext_vector_type(2)));
struct ScanArgs { const bf16 *pr, *pk, *pv, *plora; const bf16* l2t; const float *mu, *w0, *a0, *kk, *ka, *rk; bf16* wkv; float* bonus; const bf16* twa; };
constexpr int S2_NP = 7, S2_C = 16, S2_NCH = SEQ / S2_C, S2_LD = 144;
constexpr int S2_AT = 0, S2_RT = 2304, S2_BH = 4608, S2_KH = 6912, S2_VT = 9216, S2_GC = 10240;
constexpr int S2_U0 = 10496, S2_Y0 = 12544;
constexpr int S2_REG = 14592;
constexpr int S2_VT1 = 14592, S2_U01 = 15616, S2_Y01 = 17664;
template <bool D> struct S2T { static constexpr int NP = D ? 6 : 7, REG = D ? 19712 : 14592, OFF_LW = NP * REG, OFF_CST = OFF_LW + 2 * 64 * 144, NCST = 704, OFF_FLG = OFF_CST + NCST * 4, END = OFF_FLG + 128, FIRSTP = D ? 2 : 1; };
static_assert(S2T<false>::END <= RING_BYTES && S2T<true>::END <= RING_BYTES, "scan2 LDS");
__device__ __forceinline__ bf16x8 frag_lo(const LAS unsigned char* p) { const v2u a = *(const LAS v2u*)p; v4u w = (v4u){a.x, a.y, 0u, 0u}; return __builtin_bit_cast(bf16x8, w); }
__device__ __forceinline__ bf16x8 frag_2(const LAS unsigned char* p0, const LAS unsigned char* p1) { const v2u a = *(const LAS v2u*)p0, b = *(const LAS v2u*)p1; v4u w = (v4u){a.x, a.y, b.x, b.y}; return __builtin_bit_cast(bf16x8, w); }
__device__ __forceinline__ bf16x8 frag_tr_lo(const LAS unsigned char* p) { const v4i16_t a = __builtin_amdgcn_ds_read_tr16_b64_v4i16((LAS v4i16_t*)p); return (bf16x8){a[0], a[1], a[2], a[3], 0, 0, 0, 0}; }
__device__ __forceinline__ bf16x8 pack_lo(const f32x4 a) { v4u w = (v4u){pg8::cvt_pk_bf16(a[0], a[1]), pg8::cvt_pk_bf16(a[2], a[3]), 0u, 0u}; return __builtin_bit_cast(bf16x8, w); }
__device__ __forceinline__ bf16x8 pack_2(const f32x4 a, const f32x4 b) { v4u w = (v4u){pg8::cvt_pk_bf16(a[0], a[1]), pg8::cvt_pk_bf16(a[2], a[3]), pg8::cvt_pk_bf16(b[0], b[1]), pg8::cvt_pk_bf16(b[2], b[3])}; return __builtin_bit_cast(bf16x8, w); }
__device__ __forceinline__ v2u pack4(const f32x4 a) { return (v2u){pg8::cvt_pk_bf16(a[0], a[1]), pg8::cvt_pk_bf16(a[2], a[3])}; }
#define S2_SHR(x, ctl) ((x) + __builtin_bit_cast(float, __builtin_amdgcn_update_dpp(0, __builtin_bit_cast(int, (x)), (ctl), 0xF, 0xF, true)))

struct S2Raw { v4u bw[2], ba[2]; v2u cr[4], ck[4], pr[4], pk[4]; v4u cv, pv, cv1, pv1; };
template <bool D>
__device__ __forceinline__ void scan2_load(const ScanArgs& A, int b, int h, int half, int c, int lane, S2Raw& R) {
    const int tt = lane & 15, g = lane >> 4; const int tseq = c * S2_C + tt; const size_t gt = (size_t)b * SEQ + tseq; const bool hp = tseq > 0;
    const v4u z4 = (v4u){0u, 0u, 0u, 0u}; const v2u z2 = (v2u){0u, 0u};
#pragma unroll
    for (int ks = 0; ks < 2; ++ks) { const int j0 = 8 * g + 32 * ks; R.bw[ks] = *(const GAS v4u*)(A.twa + gt * 128 + j0); R.ba[ks] = *(const GAS v4u*)(A.twa + gt * 128 + 64 + j0); }
    const size_t hm = ((size_t)(b * 16 + h) * SEQ + tseq) * 64;
#pragma unroll
    for (int nt = 0; nt < 4; ++nt) { const int c0 = 16 * nt + 4 * g;
        R.cr[nt] = *(const GAS v2u*)(A.pr + hm + c0); R.ck[nt] = *(const GAS v2u*)(A.pk + hm + c0); R.pr[nt] = z2; R.pk[nt] = z2;
        if (hp) { R.pr[nt] = *(const GAS v2u*)(A.pr + hm - 64 + c0); R.pk[nt] = *(const GAS v2u*)(A.pk + hm - 64 + c0); } }
    { const size_t off = hm + (D ? 0 : half * 32) + 8 * g; R.cv = *(const GAS v4u*)(A.pv + off); R.pv = z4; if (hp) R.pv = *(const GAS v4u*)(A.pv + off - 64);
      R.cv1 = z4; R.pv1 = z4; if (D) { R.cv1 = *(const GAS v4u*)(A.pv + off + 32); if (hp) R.pv1 = *(const GAS v4u*)(A.pv + off + 32 - 64); } }
}
template <bool D>
__device__ __forceinline__ void scan2_produce(Frame& F, const ScanArgs& A, int b, int h, int half, int c, LAS unsigned char* reg, volatile LAS unsigned* flg, int pidx, int lane, const S2Raw& R) {
    const int tt = lane & 15, g = lane >> 4; const int tseq = c * S2_C + tt; const size_t gt = (size_t)b * SEQ + tseq;
    const LAS float* cst = (const LAS float*)(F.lds + RING_OFF + S2T<D>::OFF_CST);
    const LAS unsigned char* lw = F.lds + RING_OFF + S2T<D>::OFF_LW;
    const int q4 = tt >> 2, p4 = tt & 3;
    bf16x8 bw[2], ba[2];
#pragma unroll
    for (int ks = 0; ks < 2; ++ks) { bw[ks] = __builtin_bit_cast(bf16x8, R.bw[ks]); ba[ks] = __builtin_bit_cast(bf16x8, R.ba[ks]); }
    v2u cr[4], ck[4], pr_[4], pk_[4];
#pragma unroll
    for (int nt = 0; nt < 4; ++nt) { cr[nt] = R.cr[nt]; ck[nt] = R.ck[nt]; pr_[nt] = R.pr[nt]; pk_[nt] = R.pk[nt]; }
    f32x4 accw[4], acca[4];
#pragma unroll
    for (int nt = 0; nt < 4; ++nt) {
        accw[nt] = (f32x4){0.f, 0.f, 0.f, 0.f}; acca[nt] = accw[nt];
#pragma unroll
        for (int ks = 0; ks < 2; ++ks) {
            const bf16x8 fw = *(const LAS bf16x8*)(lw + (16 * nt + tt) * 144 + (8 * g + 32 * ks) * 2);
            const bf16x8 fa = *(const LAS bf16x8*)(lw + 64 * 144 + (16 * nt + tt) * 144 + (8 * g + 32 * ks) * 2);
            accw[nt] = __builtin_amdgcn_mfma_f32_16x16x32_bf16(fw, bw[ks], accw[nt], 0, 0, 0);
            acca[nt] = __builtin_amdgcn_mfma_f32_16x16x32_bf16(fa, ba[ks], acca[nt], 0, 0, 0);
        }
    }
    float ssq = 0.f; float ksvv[4][4], kvv[4][4];
#pragma unroll
    for (int nt = 0; nt < 4; ++nt) { const int c0 = 16 * nt + 4 * g;
        const float kc[4] = {bf_lo(ck[nt].x), bf_hi(ck[nt].x), bf_lo(ck[nt].y), bf_hi(ck[nt].y)}, kp[4] = {bf_lo(pk_[nt].x), bf_hi(pk_[nt].x), bf_lo(pk_[nt].y), bf_hi(pk_[nt].y)};
#pragma unroll
        for (int i = 0; i < 4; ++i) { ksvv[nt][i] = kc[i] + (kp[i] - kc[i]) * cst[192 + c0 + i]; const float kv = ksvv[nt][i] * cst[416 + c0 + i]; kvv[nt][i] = kv; ssq += kv * kv; } }
    ssq += __shfl_xor(ssq, 16); ssq += __shfl_xor(ssq, 32);
    const float inv = 1.0f / fmaxf(sqrtf(ssq), 1e-12f);
    if (c >= S2T<D>::NP) { const unsigned want = (unsigned)(c - S2T<D>::NP + 1); while (flg[8 + pidx] != want) __builtin_amdgcn_s_sleep(1); if (D) while (flg[16 + pidx] != want) __builtin_amdgcn_s_sleep(1); }
    asm volatile("" ::: "memory");
    float bon = 0.f; f32x4 vrt4[4];
#pragma unroll
    for (int nt = 0; nt < 4; ++nt) {
        const int c0 = 16 * nt + 4 * g;
        const float rc[4] = {bf_lo(cr[nt].x), bf_hi(cr[nt].x), bf_lo(cr[nt].y), bf_hi(cr[nt].y)}, rp[4] = {bf_lo(pr_[nt].x), bf_hi(pr_[nt].x), bf_lo(pr_[nt].y), bf_hi(pr_[nt].y)};
        f32x4 vat, vbh, vkh, vrt, vgc;
#pragma unroll
        for (int i = 0; i < 4; ++i) {
            const int cc = c0 + i;
            const float rsv = rc[i] + (rp[i] - rc[i]) * cst[128 + cc];
            const float ksv = ksvv[nt][i];
            const float wl = cst[288 + cc] + accw[nt][i], al = cst[352 + cc] + acca[nt][i];
            const float av = __builtin_amdgcn_rcpf(1.0f + __builtin_amdgcn_exp2f(al));
            const float kn = kvv[nt][i] * inv; const float km = ksv * (cst[640 + cc] + av * cst[480 + cc]);
            const float ld = -0.8750387749145276f * __builtin_amdgcn_rcpf(1.0f + __builtin_amdgcn_exp2f(wl));
            float L = ld; L = S2_SHR(L, 0x111); L = S2_SHR(L, 0x112); L = S2_SHR(L, 0x114); L = S2_SHR(L, 0x118);
            const float eL = __builtin_amdgcn_exp2f(L), emL = __builtin_amdgcn_rcpf(eL);
            const float eLm = __builtin_bit_cast(float, __builtin_amdgcn_update_dpp(0x3f800000, __builtin_bit_cast(int, eL), 0x111, 0xF, 0xF, false));
            vat[i] = -kn * eLm; vbh[i] = kn * av * emL; vkh[i] = km * emL; vrt[i] = rsv * eL; vgc[i] = eL;
            bon += rsv * km * cst[544 + cc];
        }
        const int o = tt * S2_LD + c0 * 2;
        *(LAS v2u*)(reg + S2_AT + o) = pack4(vat); *(LAS v2u*)(reg + S2_BH + o) = pack4(vbh); *(LAS v2u*)(reg + S2_KH + o) = pack4(vkh); *(LAS v2u*)(reg + S2_RT + o) = pack4(vrt);
        if (tt == 15) *(LAS f32x4*)(reg + S2_GC + c0 * 4) = vgc;
        vrt4[nt] = vrt;
    }
    bon += __shfl_xor(bon, 16); bon += __shfl_xor(bon, 32);
    if ((D || half == 0) && g == 0) A.bonus[gt * 16 + h] = bon;
#pragma unroll
    for (int hf = 0; hf < (D ? 2 : 1); ++hf) {
        const v4u cv = hf ? R.cv1 : R.cv, pvv = hf ? R.pv1 : R.pv; const int mo = hf ? 608 : 256, vo = hf ? S2_VT1 : S2_VT;
#pragma unroll
        for (int e2 = 0; e2 < 4; ++e2) {
            float a0 = bf_lo(cv[e2]), a1 = bf_hi(cv[e2]);
            a0 += (bf_lo(pvv[e2]) - a0) * cst[mo + 8 * g + 2 * e2]; a1 += (bf_hi(pvv[e2]) - a1) * cst[mo + 8 * g + 2 * e2 + 1];
            *(LAS unsigned short*)(reg + vo + (8 * g + 2 * e2) * 32 + tt * 2) = (unsigned short)f2bf(a0);
            *(LAS unsigned short*)(reg + vo + (8 * g + 2 * e2 + 1) * 32 + tt * 2) = (unsigned short)f2bf(a1);
        }
    }
    f32x4 cab = (f32x4){0.f, 0.f, 0.f, 0.f}, cabT = cab, cakT = cab, crbT = cab, crkT = cab;
#pragma unroll
    for (int ks = 0; ks < 2; ++ks) {
        const int o = tt * S2_LD + (8 * g + 32 * ks) * 2;
        const bf16x8 fat = *(const LAS bf16x8*)(reg + S2_AT + o), frt = *(const LAS bf16x8*)(reg + S2_RT + o), fbh = *(const LAS bf16x8*)(reg + S2_BH + o), fkh = *(const LAS bf16x8*)(reg + S2_KH + o);
        cab = __builtin_amdgcn_mfma_f32_16x16x32_bf16(fat, fbh, cab, 0, 0, 0);
        cabT = __builtin_amdgcn_mfma_f32_16x16x32_bf16(fbh, fat, cabT, 0, 0, 0);
        cakT = __builtin_amdgcn_mfma_f32_16x16x32_bf16(fkh, fat, cakT, 0, 0, 0);
        crbT = __builtin_amdgcn_mfma_f32_16x16x32_bf16(fbh, frt, crbT, 0, 0, 0);
        crkT = __builtin_amdgcn_mfma_f32_16x16x32_bf16(fkh, frt, crkT, 0, 0, 0);
    }
    f32x4 idn;
#pragma unroll
    for (int r = 0; r < 4; ++r) { const int rr = 4 * g + r;
        cab[r] = (tt < rr) ? cab[r] : 0.f;
        cabT[r] = (rr < tt) ? cabT[r] : 0.f; cakT[r] = (rr < tt) ? cakT[r] : 0.f;
        crbT[r] = (rr <= tt) ? crbT[r] : 0.f; crkT[r] = (rr <= tt) ? crkT[r] : 0.f;
        idn[r] = (rr == tt) ? 1.f : 0.f; }
    bf16x8 fT;
    {
        const f32x4 z = (f32x4){0.f, 0.f, 0.f, 0.f};
        const bf16x8 a1b = pack_lo(cab), a1a = pack_lo(cabT);
        const f32x4 a2b = __builtin_amdgcn_mfma_f32_16x16x32_bf16(a1a, a1b, z, 0, 0, 0);
        const f32x4 a2a = __builtin_amdgcn_mfma_f32_16x16x32_bf16(a1b, a1a, z, 0, 0, 0);
        f32x4 ta = cabT + idn;
        const bf16x8 p2b = pack_lo(a2b), p2a = pack_lo(a2a);
        ta = __builtin_amdgcn_mfma_f32_16x16x32_bf16(p2b, pack_lo(ta), ta, 0, 0, 0);
        const f32x4 a4b = __builtin_amdgcn_mfma_f32_16x16x32_bf16(p2a, p2b, z, 0, 0, 0), a4a = __builtin_amdgcn_mfma_f32_16x16x32_bf16(p2b, p2a, z, 0, 0, 0);
        const bf16x8 p4b = pack_lo(a4b), p4a = pack_lo(a4a);
        ta = __builtin_amdgcn_mfma_f32_16x16x32_bf16(p4b, pack_lo(ta), ta, 0, 0, 0);
        const f32x4 a8b = __builtin_amdgcn_mfma_f32_16x16x32_bf16(p4a, p4b, z, 0, 0, 0);
        ta = __builtin_amdgcn_mfma_f32_16x16x32_bf16(pack_lo(a8b), pack_lo(ta), ta, 0, 0, 0);
        fT = pack_lo(ta);
    }
    const LAS unsigned char* trb = reg + (4 * g + q4) * S2_LD + 8 * p4;
    {
        bf16x8 fa[4];
#pragma unroll
        for (int kt = 0; kt < 4; ++kt) fa[kt] = frag_tr_lo(trb + S2_AT + 32 * kt);
#pragma unroll
        for (int kt = 0; kt < 4; ++kt) { f32x4 d = (f32x4){0.f, 0.f, 0.f, 0.f}; d = __builtin_amdgcn_mfma_f32_16x16x32_bf16(fa[kt], fT, d, 0, 0, 0);
            *(LAS v2u*)(reg + S2_AT + tt * S2_LD + (16 * kt + 4 * g) * 2) = pack4(d); }
    }
    {
        const bf16x8 fak = pack_lo(cakT);
        const bf16x8 frbk = pack_2(crbT, crkT);
#pragma unroll
        for (int hf = 0; hf < (D ? 2 : 1); ++hf) {
            const int vo = hf ? S2_VT1 : S2_VT, uo = hf ? S2_U01 : S2_U0, yo = hf ? S2_Y01 : S2_Y0;
#pragma unroll
            for (int vt = 0; vt < 2; ++vt) {
                const LAS unsigned char* vp = reg + vo + (16 * vt + tt) * 32 + 8 * g;
                f32x4 x = (f32x4){0.f, 0.f, 0.f, 0.f}; x = __builtin_amdgcn_mfma_f32_16x16x32_bf16(fak, frag_lo(vp), x, 0, 0, 0);
                f32x4 u0 = (f32x4){0.f, 0.f, 0.f, 0.f}; u0 = __builtin_amdgcn_mfma_f32_16x16x32_bf16(fT, pack_lo(x), u0, 0, 0, 0);
                *(LAS f32x4*)(reg + uo + (16 * vt + tt) * 64 + 16 * g) = u0;
                const v2u vv = *(const LAS v2u*)vp; const v2u uu = pack4(u0); v4u w = (v4u){uu.x, uu.y, vv.x, vv.y};
                f32x4 y0 = (f32x4){0.f, 0.f, 0.f, 0.f}; y0 = __builtin_amdgcn_mfma_f32_16x16x32_bf16(frbk, __builtin_bit_cast(bf16x8, w), y0, 0, 0, 0);
                *(LAS f32x4*)(reg + yo + (16 * vt + tt) * 64 + 16 * g) = y0;
            }
        }
    }
    {
        const bf16x8 frb = pack_lo(crbT);
        bf16x8 fa[4]; f32x4 ci[4];
#pragma unroll
        for (int kt = 0; kt < 4; ++kt) { fa[kt] = frag_tr_lo(trb + S2_AT + 32 * kt); ci[kt] = vrt4[kt]; }
#pragma unroll
        for (int kt = 0; kt < 4; ++kt) { const f32x4 d = __builtin_amdgcn_mfma_f32_16x16x32_bf16(fa[kt], frb, ci[kt], 0, 0, 0);
            *(LAS v2u*)(reg + S2_RT + tt * S2_LD + (16 * kt + 4 * g) * 2) = pack4(d); }
    }
    asm volatile("s_waitcnt lgkmcnt(0)" ::: "memory");
    if (lane == 0) flg[pidx] = (unsigned)(c + 1);
    asm volatile("" ::: "memory");
}

template <bool D>
__device__ __forceinline__ void scan2_stage(Frame& F, const ScanArgs& A, int unit) {
    const int h = D ? unit & 15 : (unit >> 1) & 15;
    LAS unsigned char* base = F.lds + RING_OFF;
    const int tid = F.tid;
    {
        LAS float* cst = (LAS float*)(base + S2T<D>::OFF_CST);
        const int half0 = D ? 0 : (unit & 1);
        for (int i = tid; i < S2T<D>::NCST; i += 512) {
            float v;
            if (i < 64) v = A.mu[3072 + i]; else if (i < 128) v = A.mu[3136 + (i - 64)]; else if (i < 192) v = A.mu[h * 64 + (i - 128)]; else if (i < 256) v = A.mu[1024 + h * 64 + (i - 192)];
            else if (i >= 640) v = 1.0f - A.ka[h * 64 + (i - 640)];
            else if (i >= 608) v = A.mu[2048 + h * 64 + 32 + (i - 608)];
            else if (i < 288) v = A.mu[2048 + h * 64 + half0 * 32 + (i - 256)]; else if (i < 352) v = -1.4426950408889634f * A.w0[h * 64 + (i - 288)]; else if (i < 416) v = -1.4426950408889634f * A.a0[h * 64 + (i - 352)];
            else if (i < 480) v = A.kk[h * 64 + (i - 416)]; else if (i < 544) v = A.ka[h * 64 + (i - 480)]; else v = A.rk[h * 64 + (i - 544)];
            cst[i] = v;
        }
        for (int i = tid; i < 1024; i += 512) { const int mat = i >> 9, rr = (i >> 3) & 63, ch = i & 7;
            const v4u v = *(const GAS v4u*)(A.l2t + (size_t)mat * 65536 + (size_t)(h * 64 + rr) * 64 + ch * 8);
            *(LAS v4u*)(base + S2T<D>::OFF_LW + mat * 64 * 144 + rr * 144 + ch * 16) = v; }
        if (tid < 32) ((LAS unsigned*)(base + S2T<D>::OFF_FLG))[tid] = 0u;
    }
}
template <bool D>
__device__ __forceinline__ void scan2_unit(Frame& F, const ScanArgs& A, int unit, bool staged = false) {
    const int b = D ? unit >> 4 : unit >> 5, h = D ? unit & 15 : (unit >> 1) & 15;
    constexpr int S2_NP_ = S2T<D>::NP, S2_REG_ = S2T<D>::REG;
    LAS unsigned char* base = F.lds + RING_OFF;
    const int tid = F.tid, lane = F.lane, w = F.wave;
    if (!staged) { scan2_stage<D>(F, A, unit); __syncthreads(); }
    volatile LAS unsigned* flg = (volatile LAS unsigned*)(base + S2T<D>::OFF_FLG);
    if (w >= S2T<D>::FIRSTP) {
        const int half = D ? 0 : (unit & 1);
        const int pidx = w - S2T<D>::FIRSTP; LAS unsigned char* reg = base + pidx * S2_REG_;
        S2Raw R; scan2_load<D>(A, b, h, half, pidx, lane, R);
        for (int c = pidx; c < S2_NCH; c += S2_NP_) { int lane_o = lane; asm volatile("" : "+v"(lane_o));
            S2Raw Rn; if (c + S2_NP_ < S2_NCH) scan2_load<D>(A, b, h, half, c + S2_NP_, lane_o, Rn); else Rn = R;
            scan2_produce<D>(F, A, b, h, half, c, reg, flg, pidx, lane_o, R); R = Rn; }
    } else {
        const int half = D ? w : (unit & 1);
        const int vo = (D && half) ? S2_VT1 : S2_VT, uo = (D && half) ? S2_U01 : S2_U0, yo = (D && half) ? S2_Y01 : S2_Y0, cf = (D && half) ? 16 : 8;
        f32x4 st[4][2];
#pragma unroll
        for (int kt = 0; kt < 4; ++kt) { st[kt][0] = (f32x4){0.f, 0.f, 0.f, 0.f}; st[kt][1] = st[kt][0]; }
        for (int c = 0; c < S2_NCH; ++c) {
            int lane_o = lane; asm volatile("" : "+v"(lane_o));
            const int l15 = lane_o & 15, g = lane_o >> 4, q4 = l15 >> 2, p4 = l15 & 3;
            const int pidx = c % S2_NP_; const LAS unsigned char* reg = base + pidx * S2_REG_;
            { const unsigned want = (unsigned)(c + 1); while (flg[pidx] != want) __builtin_amdgcn_s_sleep(1); }
            asm volatile("" ::: "memory");
            f32x4 U[2], Y[2];
#pragma unroll
            for (int vt = 0; vt < 2; ++vt) { U[vt] = *(const LAS f32x4*)(reg + uo + (16 * vt + l15) * 64 + 16 * g); Y[vt] = *(const LAS f32x4*)(reg + yo + (16 * vt + l15) * 64 + 16 * g); }
#pragma unroll
            for (int ks = 0; ks < 2; ++ks) {
                const int o = l15 * S2_LD + (32 * ks + 4 * g) * 2;
                const bf16x8 fah = frag_2(reg + S2_AT + o, reg + S2_AT + o + 32), frh = frag_2(reg + S2_RT + o, reg + S2_RT + o + 32);
#pragma unroll
                for (int vt = 0; vt < 2; ++vt) { const bf16x8 sb = pack_2(st[2 * ks][vt], st[2 * ks + 1][vt]);
                    U[vt] = __builtin_amdgcn_mfma_f32_16x16x32_bf16(fah, sb, U[vt], 0, 0, 0); Y[vt] = __builtin_amdgcn_mfma_f32_16x16x32_bf16(frh, sb, Y[vt], 0, 0, 0); }
            }
            { bf16* yp = A.wkv + ((size_t)b * SEQ + (size_t)c * S2_C + 4 * g) * 1024 + h * 64 + half * 32 + l15;
#pragma unroll
              for (int vt = 0; vt < 2; ++vt)
#pragma unroll
                  for (int r = 0; r < 4; ++r) yp[(size_t)r * 1024 + 16 * vt] = (bf16)f2bf(Y[vt][r]); }
            bf16x8 ub[2];
#pragma unroll
            for (int vt = 0; vt < 2; ++vt) { const v2u uu = pack4(U[vt]); const v2u vv = *(const LAS v2u*)(reg + vo + (16 * vt + l15) * 32 + 8 * g); v4u wv = (v4u){uu.x, uu.y, vv.x, vv.y}; ub[vt] = __builtin_bit_cast(bf16x8, wv); }
            const LAS unsigned char* trb = reg + (4 * g + q4) * S2_LD + 8 * p4;
#pragma unroll
            for (int kt = 0; kt < 4; ++kt) {
                const bf16x8 fbk = vtr2(trb + S2_BH + 32 * kt, trb + S2_KH + 32 * kt);
                const f32x4 gc = *(const LAS f32x4*)(reg + S2_GC + (16 * kt + 4 * g) * 4);
#pragma unroll
                for (int vt = 0; vt < 2; ++vt) st[kt][vt] = __builtin_amdgcn_mfma_f32_16x16x32_bf16(fbk, ub[vt], st[kt][vt], 0, 0, 0) * gc;
            }
            asm volatile("s_waitcnt lgkmcnt(0)" ::: "memory");
            if (lane == 0) flg[cf + pidx] = (unsigned)(c + 1);
            asm volatile("" ::: "memory");
        }
    }
    __syncthreads();
}

__device__ __forceinline__ void alpha_pass(Frame& F, bf16* O, const float* LSE, int ntok = M) {
    const size_t nitems = (size_t)ntok * 96; const size_t stride = (size_t)F.G * 512;
    for (size_t it = (size_t)F.vcu * 512 + F.tid; it < nitems; it += stride) {
        const size_t t = it / 96; const int c8 = (int)(it % 96); const int head = c8 >> 3, g = head >> 2, hg = head & 3;
        const float l0 = LSE[t * NHA + hg], l1 = LSE[t * NHA + 4 + hg], l2 = LSE[t * NHA + 8 + hg];
        const float mx = fmaxf(l0, fmaxf(l1, l2));
        const float e0 = __builtin_amdgcn_exp2f(l0 - mx), e1 = __builtin_amdgcn_exp2f(l1 - mx), e2 = __builtin_amdgcn_exp2f(l2 - mx);
        const float al = (g == 0 ? e0 : (g == 1 ? e1 : e2)) / (e0 + e1 + e2);
        GAS v4u* p = (GAS v4u*)(O + t * AW + c8 * 8); const v4u v = *p; v4u o;
#pragma unroll
        for (int i = 0; i < 4; ++i) o[i] = pk2(bf_lo(v[i]) * al, bf_hi(v[i]) * al);
        *p = o;
    }
}
__device__ __forceinline__ void twa_pass(Frame& F, const bf16* plora, const float* mu, bf16* twa, int ntok = M) {
    const size_t nitems = (size_t)ntok * 16; const size_t stride = (size_t)F.G * 512;
    for (size_t it = (size_t)F.vcu * 512 + F.tid; it < nitems; it += stride) {
        const size_t t = it >> 4; const int j0 = (int)(it & 15) * 8;
        const v4u cv = *(const GAS v4u*)(plora + t * 288 + j0); v4u pv = (v4u){0u, 0u, 0u, 0u};
        if ((t & (SEQ - 1)) != 0) pv = *(const GAS v4u*)(plora + (t - 1) * 288 + j0);
        v4u o;
#pragma unroll
        for (int i = 0; i < 4; ++i) { float a = bf_lo(cv[i]), bq = bf_hi(cv[i]); a += (bf_lo(pv[i]) - a) * mu[3072 + j0 + 2 * i]; bq += (bf_hi(pv[i]) - bq) * mu[3072 + j0 + 2 * i + 1];
            if (j0 < 64) { a = 1.0f - 2.0f * __builtin_amdgcn_rcpf(1.0f + __expf(2.0f * a)); bq = 1.0f - 2.0f * __builtin_amdgcn_rcpf(1.0f + __expf(2.0f * bq)); }
            o[i] = pk2(a, bq); }
        *(GAS v4u*)(twa + t * 128 + j0) = o;
    }
}
__device__ __forceinline__ void sgd_pass(Frame& F, const bf16* plora, const float* mu, bf16* sgd, int part = 0, int ntok = M) {
    const size_t nitems = (size_t)ntok * (part ? 16 : 32); const size_t stride = (size_t)F.G * 512;
    for (size_t it = (size_t)F.vcu * 512 + F.tid; it < nitems; it += stride) {
        const size_t t = part ? (it >> 4) : (it >> 5); const int j0 = part ? ((int)(it & 15) * 8 + (part == 2 ? 128 : 0)) : (int)(it & 31) * 8; v4u o = (v4u){0u, 0u, 0u, 0u};
        if (j0 < 160) {
            const v4u cv = *(const GAS v4u*)(plora + t * 288 + 128 + j0); v4u pv = (v4u){0u, 0u, 0u, 0u};
            if ((t & (SEQ - 1)) != 0) pv = *(const GAS v4u*)(plora + (t - 1) * 288 + 128 + j0);
#pragma unroll
            for (int i = 0; i < 4; ++i) { float a = bf_lo(cv[i]), bq = bf_hi(cv[i]); a += (bf_lo(pv[i]) - a) * mu[3200 + j0 + 2 * i]; bq += (bf_hi(pv[i]) - bq) * mu[3200 + j0 + 2 * i + 1];
                o[i] = pk2(fsigmoid(a), fsigmoid(bq)); }
        }
        *(GAS v4u*)(sgd + t * 256 + j0) = o;
    }
}

__device__ __forceinline__ void sub_barrier(gu32* cnt, unsigned n, int tid, bool same_xcd = false) {
    asm volatile("s_waitcnt vmcnt(0)" ::: "memory");
    __syncthreads();
    if (tid == 0) {
        if (!same_xcd) __builtin_amdgcn_fence(__ATOMIC_RELEASE, "agent");
        asm volatile("s_waitcnt vmcnt(0)" ::: "memory");
        (void)__hip_atomic_fetch_add(cnt, 1u, __ATOMIC_RELAXED, __HIP_MEMORY_SCOPE_AGENT);
        while (__hip_atomic_load(cnt, __ATOMIC_RELAXED, __HIP_MEMORY_SCOPE_AGENT) < n) __builtin_amdgcn_s_sleep(2);
        __builtin_amdgcn_fence(__ATOMIC_ACQUIRE, "agent");
        asm volatile("s_waitcnt vmcnt(0)" ::: "memory");
    }
    __syncthreads();
}
#define P_(T, off) ((T*)(ws + (off)))
#define xb0 ((bf16*)out)
#define W1T P_(bf16, WS_W1T)
#define W2T P_(bf16, WS_W2T)
#define WIN P_(bf16, WS_WIN)
#define WG P_(bf16, WS_WG)
#define WA P_(bf16, WS_WA)
#define WB P_(bf16, WS_WB)
#define WO P_(bf16, WS_WO)
#define G2T P_(bf16, WS_G2T)
#define W3T P_(bf16, WS_W3T)
#define W4T P_(bf16, WS_W4T)
#define L2T P_(bf16, WS_L2T)
#define SS0 P_(float, WS_SS0)
#define SS1 P_(float, WS_SS1)
#define SS2 P_(float, WS_SS2)
#define LSE P_(float, WS_LSE)
#define BON P_(float, WS_BON)
#define ACT P_(bf16, WS_ACT)
#define PR P_(bf16, WS_PR)
#define PK P_(bf16, WS_PK)
#define PV P_(bf16, WS_PV)
#define GATES P_(bf16, WS_GATES)
#define LORA P_(bf16, WS_LORA)
#define AQ P_(bf16, WS_AQ)
#define AK P_(bf16, WS_AK)
#define AV P_(bf16, WS_AV)
#define WKV P_(bf16, WS_WKV)
#define SGD P_(bf16, WS_SGD)
#define GATES_OUT ((bf16*)out)
#define XB1 P_(bf16, WS_XB1)
#define MRG P_(bf16, WS_MRG)
#define XB2 P_(bf16, WS_XB2)
#define TWA P_(bf16, WS_TWA)
struct Args { const float* in[26]; float* out; unsigned char* ws; int ph_lo, ph_hi, rep_ph, rep_n; };
__global__ void __launch_bounds__(NWAVES * 64, 2) mk_fwd(Args args) {
    extern __shared__ __attribute__((aligned(16))) unsigned char lds[];
    Frame F;
    F.lds = (LAS unsigned char*)lds;
    F.MISC = (volatile LAS unsigned*)(F.lds + MISC_OFF);
    F.tid = threadIdx.x; F.lane = F.tid & 63; F.wave = __builtin_amdgcn_readfirstlane(F.tid >> 6);
    F.G = gridDim.x; { const int bx = blockIdx.x; F.vcu = (F.G % 8 == 0) ? (bx % 8) * (F.G / 8) + bx / 8 : bx; }
    unsigned char* ws = args.ws;
    F.ctl = (gu32*)(ws + WS_CTL);
    for (int u = F.tid; u < (LDS_BYTES - LDSCTL_OFF) / 4; u += NWAVES * 64) ((LAS unsigned*)(F.lds + LDSCTL_OFF))[u] = 0u;
    __syncthreads();
    XcdBarrier bar; bar.bar = (unsigned*)(F.ctl + CW_BAR); bar.x = 0; bar.st = nullptr;
    if (N_LAUNCHES == 1) bar = xcd_barrier_post((unsigned*)(F.ctl + CW_BAR), F.MISC + 8);
    if (F.tid == 0) (void)__hip_atomic_fetch_or(F.ctl + CW_GRPM + 64 * ((int)blockIdx.x & 7), 1u << (bar.x & 31u), __ATOMIC_RELAXED, __HIP_MEMORY_SCOPE_AGENT);
#ifdef BAR_TWICE
#define GRID_BAR() do { if (N_LAUNCHES == 1) { xcd_barrier(bar); xcd_barrier(bar); } } while (0)
#else
#define GRID_BAR() do { if (N_LAUNCHES == 1) xcd_barrier(bar); } while (0)
#endif
    unsigned grp_uses = 0; bool grp_one_xcd = false;
#define GROUP_BAR() do { if (N_LAUNCHES == 1) { if (F.G == 256) sub_barrier(F.ctl + CW_GRP + 64 * ((int)blockIdx.x & 7), 32u * (++grp_uses), F.tid, grp_one_xcd); else xcd_barrier(bar); } } while (0)
    const int lo = args.ph_lo, hi = args.ph_hi;
#ifndef PHMASK
#define PHMASK 0x7ff
#endif
#define IN(k) (((PHMASK >> (k)) & 1) && lo <= (k) && (k) < hi)
#define BOTH(k) (IN(k) && IN((k) + 1))
#define REP(k) for (int rep_ = 0, nrep_ = (args.rep_ph == (k) ? args.rep_n : 1); rep_ < nrep_; ++rep_)
    const float* x = args.in[0];
    float* out = args.out;
    const int cid = (int)blockIdx.x;

    if (IN(0)) { REP(0) { P0Args pa; for (int i = 0; i < 26; ++i) pa.in[i] = args.in[i]; pa.ws = ws; pa.out = out; p0_prologue(F, pa, 0, F.vcu * NWAVES + F.wave, F.G * NWAVES);
        if (F.G == 256) p0_prologue(F, pa, 1, F.vcu * NWAVES + F.wave, F.G * NWAVES); }
        if (BOTH(0)) GRID_BAR(); }
    if (N_LAUNCHES == 1 && IN(0)) { const unsigned m_ = (unsigned)__builtin_amdgcn_readfirstlane((int)__hip_atomic_load(F.ctl + CW_GRPM + 64 * ((int)blockIdx.x & 7), __ATOMIC_RELAXED, __HIP_MEMORY_SCOPE_AGENT)); grp_one_xcd = __builtin_popcount(m_) == 1; }
#ifdef SHADOW_P1
#ifdef SHADOW_ZERO
    if (IN(1)) { pg8::Gemm g{XB2, W3T, M, 2 * FF, D};
#else
    if (IN(1)) { pg8::Gemm g{xb0, W1T, M, 2 * FF, D};
#endif
        pg8::SameTileOrder S; S.init(M, 2 * FF, F.G, cid); pg8::EpiSwiglu E{ACT, SS0};
        pg8::gemm_phase<pg8::EpiSwiglu, pg8::SameTileOrder, true, true>(F.lds + RING_OFF, g, S, E); GRID_BAR(); }
#endif
    if (IN(1)) { REP(1) { pg8::Gemm g{xb0, W1T, M, 2 * FF, D, 3}; pg8::StaticOrder S; S.init(M, 2 * FF, F.G, cid); pg8::EpiSwiglu E{ACT, SS0};
        pg8::gemm_phase<pg8::EpiSwiglu, pg8::StaticOrder, true, true>(F.lds + RING_OFF, g, S, E); } if (BOTH(1)) GROUP_BAR(); }
    if (IN(2)) { REP(2) { pg8::Gemm g{ACT, W2T, M, D, FF, 3}; pg8::StaticOrder S; S.init(M, D, F.G, cid); pg8::EpiResid<true, false, true> E{xb0, nullptr, XB1, SS1, 0.5f};
        pg8::gemm_phase<pg8::EpiResid<true, false, true>, pg8::StaticOrder, true, true>(F.lds + RING_OFF, g, S, E); } if (BOTH(2)) GROUP_BAR(); }
    if (IN(3)) { pg8::EpiMix E{ws, SS1, args.in[18], args.in[19]};
        if (F.G == 256) {
            pg8::Gemm g{XB1, WIN, M, 23 * 256, D, 3}; pg8::SkipOrder S; S.init2(M, 22 * 256, F.G, cid, 13);
            REP(3) pg8::gemm_phase<pg8::EpiMix, pg8::SkipOrder, true, true>(F.lds + RING_OFF, g, S, E);
        } else {
            pg8::Gemm g{XB1, WIN, M, 23 * 256, D, 3}; pg8::StaticOrder S; S.init(M, 23 * 256, F.G, cid);
            if (cid >= F.G / 2) { P0Args pa; for (int i = 0; i < 26; ++i) pa.in[i] = args.in[i]; pa.ws = ws; pa.out = out; p0_prologue(F, pa, 1, (cid - F.G / 2) * NWAVES + F.wave, (F.G - F.G / 2) * NWAVES);
                __syncthreads(); }
            pg8::gemm_phase<pg8::EpiMix, pg8::StaticOrder, true, true>(F.lds + RING_OFF, g, S, E);
        }
        if (BOTH(3)) GROUP_BAR(); }
    if (IN(4)) { if (args.rep_ph == 4) attn_phase(F, cid, F.G, NB_ * NHA * 32, AQ, AK, AV, AQ, LSE, false);
        if (F.G == 256) {
            const int g_ = (int)blockIdx.x & 7, j_ = (int)blockIdx.x >> 3;
            attn_phase(F, g_ * (NHA * 32) + j_, 32, (g_ + 1) * (NHA * 32), AQ, AK, AV, AQ, LSE, true);
            Frame F2 = F; F2.vcu = j_; F2.G = 32; twa_pass(F2, LORA + (size_t)g_ * SEQ * 288, args.in[7], TWA + (size_t)g_ * SEQ * 128, SEQ);
        } else { attn_phase(F, cid, F.G, NB_ * NHA * 32, AQ, AK, AV, AQ, LSE, true); twa_pass(F, LORA, args.in[7], TWA); }
        if (F.G == 256 && IN(5)) { const int bx = (int)blockIdx.x; if (!((bx >> 3) & 1)) {
            ScanArgs sa{PR, PK, PV, LORA, L2T, args.in[7], args.in[8], args.in[10], args.in[13], args.in[14], args.in[15], WKV, BON, TWA};
            scan2_stage<true>(F, sa, (bx & 7) * 16 + (bx >> 4)); } }
        if (BOTH(4)) GROUP_BAR(); }
    if (IN(5)) {
        ScanArgs sa{PR, PK, PV, LORA, L2T, args.in[7], args.in[8], args.in[10], args.in[13], args.in[14], args.in[15], WKV, BON, TWA};
        if (F.G == 256) {
            const int bx = (int)blockIdx.x; const int role = (bx >> 3) & 1, sub = (bx & 7) | ((bx >> 4) << 3);
            if (!role) scan2_unit<true>(F, sa, (bx & 7) * 16 + (bx >> 4), IN(4));
            else {
                Frame F2 = F; F2.vcu = sub >> 3; F2.G = 16; const int gb = sub & 7;
                alpha_pass(F2, AQ + (size_t)gb * SEQ * AW, LSE + (size_t)gb * SEQ * NHA, SEQ); sgd_pass(F2, LORA + (size_t)gb * SEQ * 288, args.in[7], SGD + (size_t)gb * SEQ * 256, 1, SEQ);
                __syncthreads();
                { pg8::Gemm g13{XB1, WIN, M, 23 * 256, D, 3}; pg8::ColsOrder S13; S13.init2(M, 256, 128, sub, 13); pg8::EpiMix E13{ws, SS1, args.in[18], args.in[19]};
                  pg8::gemm_phase<pg8::EpiMix, pg8::ColsOrder, true, true>(F.lds + RING_OFF, g13, S13, E13); }
                pg8::Gemm g{XB1, WG, M, 2 * D, D, 3}; pg8::StaticOrder S; S.init(M, 2 * D, 128, sub); pg8::EpiGates E{GATES_OUT, SS1, args.in[6]};
                pg8::gemm_phase<pg8::EpiGates, pg8::StaticOrder, true, true>(F.lds + RING_OFF, g, S, E);
                sub_barrier(F.ctl + CW_SUB2 + 64 * gb, 16u, F.tid, grp_one_xcd);
                sgd_pass(F2, LORA + (size_t)gb * SEQ * 288, args.in[7], SGD + (size_t)gb * SEQ * 256, 2, SEQ);
            }
        } else {
            REP(5) for (int u = cid; u < NB_ * 32; u += F.G) scan2_unit<false>(F, sa, u);
            alpha_pass(F, AQ, LSE); REP(12) sgd_pass(F, LORA, args.in[7], SGD);
        }
        if (BOTH(5)) GROUP_BAR(); }
    if (IN(6)) {
        if (F.G != 256) { pg8::Gemm g{XB1, WG, M, 2 * D, D, 3}; pg8::StaticOrder S; S.init(M, 2 * D, F.G, cid); pg8::EpiGates E{GATES_OUT, SS1, args.in[6]};
          REP(6) pg8::gemm_phase<pg8::EpiGates, pg8::StaticOrder, true, true>(F.lds + RING_OFF, g, S, E); }
        const bool projb_first = (F.G == 256) && (((int)blockIdx.x & 1) != 0);
        if (projb_first && IN(7)) { pg8::Gemm g{AQ, WB, M, D, AW, 2}; pg8::StaticOrder S; S.init(M, D, F.G, cid); pg8::EpiProj<false, 1> E{MRG, GATES_OUT};
          pg8::gemm_phase<pg8::EpiProj<false, 1>, pg8::StaticOrder, true, true>(F.lds + RING_OFF, g, S, E); }
        { pg8::Gemm g{SGD, G2T, M, D, 256, 2}; pg8::StaticOrder S; S.init(M, D, F.G, cid); pg8::EpiGn E{WKV, PV, BON, args.in[7] + 2048, args.in[16], args.in[17]};
          pg8::gemm_phase<pg8::EpiGn, pg8::StaticOrder, true, true>(F.lds + RING_OFF, g, S, E); }
        if (BOTH(6)) GROUP_BAR(); }
    if (IN(7)) {
        const bool projb_first = (F.G == 256) && (((int)blockIdx.x & 1) != 0) && IN(6);
        if (projb_first) {
            pg8::Gemm g{WKV, WA, M, D, D, 2}; pg8::StaticOrder S; S.init(M, D, F.G, cid); pg8::EpiProj<true, 0> E{MRG, GATES_OUT};
            pg8::gemm_phase<pg8::EpiProj<true, 0>, pg8::StaticOrder, true, true>(F.lds + RING_OFF, g, S, E);
        } else {
            { pg8::Gemm g{WKV, WA, M, D, D, 2}; pg8::StaticOrder S; S.init(M, D, F.G, cid); pg8::EpiProj<false, 0> E{MRG, GATES_OUT};
              REP(7) pg8::gemm_phase<pg8::EpiProj<false, 0>, pg8::StaticOrder, true, true>(F.lds + RING_OFF, g, S, E); }
            { pg8::Gemm g{AQ, WB, M, D, AW, 2}; pg8::StaticOrder S; S.init(M, D, F.G, cid); pg8::EpiProj<true, 1> E{MRG, GATES_OUT};
              pg8::gemm_phase<pg8::EpiProj<true, 1>, pg8::StaticOrder, true, true>(F.lds + RING_OFF, g, S, E); }
        }
        if (BOTH(7)) GROUP_BAR(); }
    if (IN(8)) { pg8::Gemm g{MRG, WO, M, D, D, 3}; pg8::StaticOrder S; S.init(M, D, F.G, cid); pg8::EpiResid<true, false, true> E{XB1, nullptr, XB2, SS2, 1.0f};
        pg8::gemm_phase<pg8::EpiResid<true, false, true>, pg8::StaticOrder, true, true>(F.lds + RING_OFF, g, S, E); if (BOTH(8)) GROUP_BAR(); }
    if (IN(9)) { pg8::Gemm g{XB2, W3T, M, 2 * FF, D, 3}; pg8::StaticOrder S; S.init(M, 2 * FF, F.G, cid); pg8::EpiSwiglu E{ACT, SS2};
        REP(9) pg8::gemm_phase<pg8::EpiSwiglu, pg8::StaticOrder, true, true>(F.lds + RING_OFF, g, S, E); if (BOTH(9)) GROUP_BAR(); }
    if (IN(10)) { pg8::Gemm g{ACT, W4T, M, D, FF, 3}; pg8::StaticOrder S; S.init(M, D, F.G, cid); pg8::EpiResid<true, true, false> E{XB2, out, nullptr, nullptr, 0.5f};
        REP(10) pg8::gemm_phase<pg8::EpiResid<true, true, false>, pg8::StaticOrder, true, true>(F.lds + RING_OFF, g, S, E); }

#undef IN
#undef BOTH
}

extern "C" void kernel_launch(void* const* d_in, const int* in_sizes, int n_in, void* d_out, int out_size, void* d_ws, size_t ws_size, hipStream_t stream) {
    static int grid = 0;
    if (grid == 0) {
        if (n_in != 26 || in_sizes[0] != M * D || out_size != M * D || ws_size < WS_END) { fprintf(stderr, "kernel_launch: unexpected shapes: n_in %d in0 %d out %d ws %zu (need %zu)\n", n_in, n_in > 0 ? in_sizes[0] : -1, out_size, ws_size, (size_t)WS_END); grid = -1; return; }
        int dev = 0, cus = 0, per_cu = 0;
        if (hipGetDevice(&dev) != hipSuccess || hipDeviceGetAttribute(&cus, hipDeviceAttributeMultiprocessorCount, dev) != hipSuccess) { grid = -1; return; }
        if (hipFuncSetAttribute((const void*)mk_fwd, hipFuncAttributeMaxDynamicSharedMemorySize, LDS_BYTES) != hipSuccess) { fprintf(stderr, "kernel_launch: hipFuncSetAttribute failed\n"); grid = -1; return; }
        if (hipOccupancyMaxActiveBlocksPerMultiprocessor(&per_cu, (const void*)mk_fwd, NWAVES * 64, LDS_BYTES) != hipSuccess || per_cu < 1) fprintf(stderr, "kernel_launch: occupancy query reports %d per CU\n", per_cu);
        (void)hipGetLastError();
        grid = cus;
    }
    if (grid < 0) return;
    if (hipMemsetAsync((char*)d_ws + WS_CTL, 0, CTL_ZERO_BYTES, stream) != hipSuccess) return;
#ifdef SHADOW_ZERO
    (void)hipMemsetAsync((char*)d_ws + WS_XB2, 0, (size_t)M * D * 2, stream); (void)hipMemsetAsync((char*)d_ws + WS_W3T, 0, (size_t)2 * FF * D * 2, stream);
#endif
    Args a{};
    for (int i = 0; i < 26; ++i) a.in[i] = (const float*)d_in[i];
    a.out = (float*)d_out; a.ws = (unsigned char*)d_ws;
#ifndef REP_PH
#define REP_PH -1
#endif
#ifndef REP_N
#define REP_N 1
#endif
    a.rep_ph = REP_PH; a.rep_n = REP_N;
    if (N_LAUNCHES == 1) { a.ph_lo = 0; a.ph_hi = NPH; hipLaunchKernelGGL(mk_fwd, dim3(grid), dim3(NWAVES * 64), LDS_BYTES, stream, a); }
    else for (int li = 0; li < NPH; ++li) { a.ph_lo = li; a.ph_hi = li + 1; hipLaunchKernelGGL(mk_fwd, dim3(grid), dim3(NWAVES * 64), LDS_BYTES, stream, a); }
}
```

```cpp
#include <hip/hip_runtime.h>
#include <cstdio>
#include <cstdint>
constexpr int NWAVES = 8;
constexpr int NB_ = 8, SEQ = 4096, D = 1024, FF = 2816, M = NB_ * SEQ;
constexpr int RW_COLS = 3360, IN_COLS = 7712, AW = 768, NHA = 12;
constexpr int NPH = 11;
#ifndef MK_N_LAUNCHES
#define MK_N_LAUNCHES 1
#endif
constexpr int N_LAUNCHES = MK_N_LAUNCHES;

constexpr size_t MiB = 1u << 20;
constexpr size_t WS_CTL = 0, CTL_ZERO_BYTES = 64 * 1024;
constexpr size_t WS_W1T = 1 * MiB;
constexpr size_t WS_W2T = 12 * MiB;
constexpr size_t WS_WIN = 17 * MiB + 512 * 1024;
constexpr size_t WS_WG  = 29 * MiB;
constexpr size_t WS_WA  = 33 * MiB;
constexpr size_t WS_WB  = 35 * MiB;
constexpr size_t WS_WO  = 36 * MiB + 512 * 1024;
constexpr size_t WS_G2T = 38 * MiB + 512 * 1024;
constexpr size_t WS_W3T = 39 * MiB;
constexpr size_t WS_W4T = 50 * MiB;
constexpr size_t WS_L2T = 55 * MiB + 512 * 1024;
constexpr size_t WS_SS0 = 56 * MiB, WS_SS1 = 58 * MiB, WS_SS2 = 60 * MiB;
constexpr size_t WS_LSE = 62 * MiB;
constexpr size_t WS_BON = 64 * MiB;
constexpr size_t WS_ACT = 66 * MiB;
constexpr size_t WS_PR = 66 * MiB, WS_PK = 130 * MiB, WS_PV = 194 * MiB;
constexpr size_t WS_GATES = 66 * MiB;
constexpr size_t WS_LORA = 258 * MiB;
constexpr size_t WS_AQ = 276 * MiB, WS_AK = 324 * MiB, WS_AV = 372 * MiB;
constexpr size_t WS_WKV = 324 * MiB;
constexpr size_t WS_SGD = 388 * MiB;
constexpr size_t WS_XB1 = 420 * MiB;
constexpr size_t WS_MRG = 130 * MiB;
constexpr size_t WS_XB2 = 276 * MiB;
constexpr size_t WS_TWA = 484 * MiB;
constexpr size_t WS_END = 492 * MiB;
constexpr int CW_BAR = 4096, CW_SUB = 8192, CW_GRP = 8320, CW_GRPM = 8896, CW_SUB2 = 9472;

constexpr int RING_OFF = 0, RING_BYTES = 162816;
constexpr int LDSCTL_OFF = RING_BYTES, MISC_OFF = LDSCTL_OFF + 320;
constexpr int LDS_BYTES = 163840;

namespace pg8 {
#define PG8_LAS __attribute__((address_space(3)))
typedef unsigned short bf16_t;
typedef short bf16x8 __attribute__((ext_vector_type(8)));
typedef float f32x4 __attribute__((ext_vector_type(4)));
typedef unsigned u32x4 __attribute__((ext_vector_type(4)));
constexpr int BM = 256, BK = 64, HALF = 128, HTB = HALF * BK * 2  , STAGE_BYTES = 8 * HTB, NXCD = 8, WGM = 8;

__host__ __device__ __forceinline__ int lds_byte(int r, int c) { const int st = (r >> 4) * 2 + (c >> 5), rr = r & 15, cc = c & 31, ob = rr * 64 + cc * 2; return st * 1024 + (ob ^ (((ob >> 9) & 1) << 5)); }
__host__ __device__ __forceinline__ void stage_rc(int b, int& R, int& C) { const int st = b / 1024, sb = b % 1024, swz = sb ^ (((sb >> 9) & 1) << 5); R = (st >> 1) * 16 + swz / 64; C = (st & 1) * 32 + (swz % 64) / 2; }
__host__ __device__ __forceinline__ int perm32(int rho) { const int n = rho >> 4, i = rho & 15; return 8 * (i >> 2) + 4 * n + (i & 3); }

struct Unit { int pm, pn; };
struct Gemm { const bf16_t* A; const bf16_t* Bt; int M, N, K; int blk = 0; };

struct StaticOrder {
    int nM, nN, nwg, G, c;
    __host__ __device__ void init(int M, int N, int G_, int c_) { nM = M / BM; nN = N / BM; nwg = nM * nN; G = G_; c = c_; }
    __host__ __device__ bool next(int i, Unit& u) const {
        const long L = (long)i * G + c; if (L >= nwg) return false;
        int wgid = (int)L; { const int q = nwg / NXCD, r = nwg % NXCD, xcd = wgid % NXCD, off = wgid / NXCD; wgid = (xcd < r ? xcd * (q + 1) : r * (q + 1) + (xcd - r) * q) + off; }
        const int nig = WGM * nN, gid = wgid / nig, fm = gid * WGM, gsz = (nM - fm) < WGM ? (nM - fm) : WGM;
        u.pm = fm + ((wgid % nig) % gsz); u.pn = (wgid % nig) / gsz; return true;
    }
    __device__ __forceinline__ void a_ready(const Unit&) const {}
    __device__ __forceinline__ void pre_store(const Unit&) const {}
    __device__ __forceinline__ void done(const Unit&) const {}
};
template <class Base> struct Guarded : Base {
    const unsigned* gcnt; unsigned target; int gstride; mutable bool armed;
    __device__ __forceinline__ void arm(const unsigned* c, int stride_dw, unsigned t, bool on) { gcnt = c; gstride = stride_dw; target = t; armed = on; }
    __device__ __forceinline__ void pre_store(const Unit&) const {
        if (armed) { armed = false; const unsigned* p = gcnt + gstride * ((int)threadIdx.x & 7);
            if (((int)threadIdx.x & 63) < 8) while (__hip_atomic_load(p, __ATOMIC_RELAXED, __HIP_MEMORY_SCOPE_AGENT) < target) __builtin_amdgcn_s_sleep(1);
            asm volatile("" ::: "memory"); }
    }
};
struct ColsOrder : StaticOrder { int pn0; __host__ __device__ void init2(int M, int N, int G_, int c_, int pn0_) { init(M, N, G_, c_); pn0 = pn0_; }
    __host__ __device__ bool next(int i, Unit& u) const { if (!StaticOrder::next(i, u)) return false; u.pn += pn0; return true; } };
struct SkipOrder : StaticOrder { int skip; __host__ __device__ void init2(int M, int N, int G_, int c_, int skip_) { init(M, N, G_, c_); skip = skip_; }
    __host__ __device__ bool next(int i, Unit& u) const { if (!StaticOrder::next(i, u)) return false; u.pn += (u.pn >= skip) ? 1 : 0; return true; } };
struct SameTileOrder : StaticOrder { __host__ __device__ bool next(int i, Unit& u) const { Unit t; if (!StaticOrder::next(i, t)) return false; return StaticOrder::next(0, u); } };
typedef float f32x2c_t __attribute__((ext_vector_type(2))); typedef __bf16 bf16x2c_t __attribute__((ext_vector_type(2)));
__device__ __forceinline__ unsigned cvt_pk_bf16(float lo, float hi) { f32x2c_t v = {lo, hi}; bf16x2c_t b = __builtin_convertvector(v, bf16x2c_t); return __builtin_bit_cast(unsigned, b); }
typedef float f32x2 __attribute__((ext_vector_type(2)));
__device__ __forceinline__ float fast_sigmoid(float x) { return __builtin_amdgcn_rcpf(1.0f + __expf(-x)); }
__device__ __forceinline__ float row_scale_from_ss(const float* ss, int row, int fq) {
    const f32x4 a = *(const f32x4*)(ss + (size_t)row * 16 + 4 * fq);
    float s = (a[0] + a[1]) + (a[2] + a[3]);
    s += __shfl_xor(s, 16); s += __shfl_xor(s, 32);
    return __builtin_amdgcn_rsqf(s * (1.0f / 1024.0f) + 1e-6f);
}
__device__ __forceinline__ u32x4 pack8(const f32x4 a, const f32x4 b) { u32x4 w; w.x = cvt_pk_bf16(a[0], a[1]); w.y = cvt_pk_bf16(a[2], a[3]); w.z = cvt_pk_bf16(b[0], b[1]); w.w = cvt_pk_bf16(b[2], b[3]); return w; }
__device__ __forceinline__ void unpack8(const u32x4 w, f32x4& a, f32x4& b) {
    a[0] = __uint_as_float(w.x << 16); a[1] = __uint_as_float(w.x & 0xffff0000u); a[2] = __uint_as_float(w.y << 16); a[3] = __uint_as_float(w.y & 0xffff0000u);
    b[0] = __uint_as_float(w.z << 16); b[1] = __uint_as_float(w.z & 0xffff0000u); b[2] = __uint_as_float(w.w << 16); b[3] = __uint_as_float(w.w & 0xffff0000u);
}
#ifdef WT_STORES
__device__ __forceinline__ void st16(void* p, const u32x4 v) { asm volatile("global_store_dwordx4 %0, %1, off sc1\n\ts_nop 1" :: "v"(p), "v"(v) : "memory"); }
#else
__device__ __forceinline__ void st16(void* p, const u32x4 v) { *(u32x4*)p = v; }
#endif
__device__ __forceinline__ void st16f(float* p, const f32x4 v) { st16((void*)p, __builtin_bit_cast(u32x4, v)); }
constexpr int FFN_HID = 2816;
__device__ __forceinline__ size_t boff(int row, int col) { return (size_t)(row >> 8) * (256 * 1024) + (size_t)(col >> 6) * (256 * 64) + (size_t)((row & 255) * 64 + (col & 63)); }
struct PreNone {};
struct PreRows { float v[8]; };
__device__ __forceinline__ void load_rows_ss(const float* ss, const Unit& u, int wr, int fr, PreRows& P) {
#pragma unroll
    for (int ai = 0; ai < 2; ++ai)
#pragma unroll
        for (int m = 0; m < 4; ++m) P.v[4 * ai + m] = ss[u.pm * BM + ai * HALF + wr * 64 + m * 16 + fr];
}
__device__ __forceinline__ float scale_of(float ssq) { return __builtin_amdgcn_rsqf(ssq * (1.0f / 1024.0f) + 1e-6f); }

struct EpiSwiglu {
    static constexpr bool PERM = true, AFTER_DRAIN = false, TWICE_OK = true; static constexpr bool Z64 = true;
    typedef PreRows Pre;
    bf16_t* O; const float* ss;
    __device__ __forceinline__ void pre(const Unit& u, int wr, int fr, Pre& P) const { load_rows_ss(ss, u, wr, fr, P); }
    __device__ __forceinline__ void operator()(const f32x4 (&acc)[2][2][4][2], const Unit& u, int wr, int wc, int fr, int fq, const Pre& P) const {
        const int row0 = u.pm * BM + wr * 64 + fr, col0 = u.pn * 128 + wc * 32 + 8 * fq;
#pragma unroll
        for (int ai = 0; ai < 2; ++ai)
#pragma unroll
            for (int m = 0; m < 4; ++m) {
                const int row = row0 + ai * HALF + m * 16; const float s = scale_of(P.v[4 * ai + m]); const float sn = -1.4426950408889634f * s, s2 = s * s;
                f32x4 o[2];
#pragma unroll
                for (int n = 0; n < 2; ++n) {
                    const f32x4 a = acc[ai][0][m][n], b = acc[ai][1][m][n]; const f32x4 t = a * sn; f32x4 e, r;
#pragma unroll
                    for (int i = 0; i < 4; ++i) e[i] = __builtin_amdgcn_exp2f(t[i]);
                    const f32x4 d = e + 1.0f;
#pragma unroll
                    for (int i = 0; i < 4; ++i) r[i] = __builtin_amdgcn_rcpf(d[i]);
                    o[n] = (a * b) * (r * s2); }
                st16(O + (size_t)(row >> 8) * (256 * FFN_HID) + (size_t)(col0 >> 6) * (256 * 64) + (row & 255) * 64 + (col0 & 63), pack8(o[0], o[1]));
            }
    }
};

template <bool SRC_BF16, bool OUT_F32, bool OUT_BF16> struct EpiResid {
    static constexpr bool PERM = true, AFTER_DRAIN = false, TWICE_OK = false; static constexpr bool Z64 = true;
    typedef PreNone Pre;
    const void* base; float* out; bf16_t* xb; float* ss; float scale;
    __device__ __forceinline__ void pre(const Unit&, int, int, Pre&) const {}
    __device__ __forceinline__ void operator()(const f32x4 (&acc)[2][2][4][2], const Unit& u, int wr, int wc, int fr, int fq, const Pre&) const {
        const int row0 = u.pm * BM + wr * 64 + fr, col0 = u.pn * BM + wc * 32 + 8 * fq;
        u32x4 raw[2][4][2];
        if (SRC_BF16) {
#pragma unroll
            for (int ai = 0; ai < 2; ++ai)
#pragma unroll
                for (int m = 0; m < 4; ++m)
#pragma unroll
                    for (int bj = 0; bj < 2; ++bj) raw[ai][m][bj] = __builtin_nontemporal_load((const u32x4*)((const bf16_t*)base + boff(row0 + ai * HALF + m * 16, col0 + bj * HALF)));
        }
#pragma unroll
        for (int ai = 0; ai < 2; ++ai)
#pragma unroll
            for (int m = 0; m < 4; ++m) {
                const int row = row0 + ai * HALF + m * 16; const size_t off = (size_t)row * 1024 + col0; float q = 0.f;
#pragma unroll
                for (int bj = 0; bj < 2; ++bj) {
                    f32x4 b0, b1;
                    if (SRC_BF16) unpack8(raw[ai][m][bj], b0, b1);
                    else { b0 = *(const f32x4*)((const float*)base + off + bj * HALF); b1 = *(const f32x4*)((const float*)base + off + bj * HALF + 4); }
                    const f32x4 o0 = b0 + acc[ai][bj][m][0] * scale, o1 = b1 + acc[ai][bj][m][1] * scale;
                    if (OUT_F32) { __builtin_nontemporal_store(o0, (f32x4*)(out + off + bj * HALF)); __builtin_nontemporal_store(o1, (f32x4*)(out + off + bj * HALF + 4)); }
                    if (OUT_BF16) {
                        st16(xb + boff(row, col0 + bj * HALF), pack8(o0, o1));
                        q += (o0[0] * o0[0] + o0[1] * o0[1]) + (o0[2] * o0[2] + o0[3] * o0[3]) + (o1[0] * o1[0] + o1[1] * o1[1]) + (o1[2] * o1[2] + o1[3] * o1[3]);
                    }
                }
                if (OUT_BF16) { q += __shfl_xor(q, 16); q += __shfl_xor(q, 32); if (fq == 0) atomicAdd(ss + row, q); }
            }
    }
};

__device__ __forceinline__ size_t hmoff(int row, int col) { return ((size_t)((row >> 12) * 16 + (col >> 6)) * 4096 + (size_t)(row & 4095)) * 64 + (size_t)(col & 63); }
__device__ __forceinline__ size_t hm12(int row, int col) { return ((size_t)((row >> 12) * 12 + (col >> 6)) * 4096 + (size_t)(row & 4095)) * 64 + (size_t)(col & 63); }
struct EpiMix {
    static constexpr bool PERM = true, AFTER_DRAIN = false, TWICE_OK = true; static constexpr bool Z64 = true;
    typedef PreRows Pre;
    unsigned char* ws; const float* ss; const float* qgain; const float* kgain;
    __device__ __forceinline__ void pre(const Unit& u, int wr, int fr, Pre& P) const { load_rows_ss(ss, u, wr, fr, P); }
    __device__ __forceinline__ void operator()(const f32x4 (&acc)[2][2][4][2], const Unit& u, int wr, int wc, int fr, int fq, const Pre& P) const {
        const int row0 = u.pm * BM + wr * 64 + fr; const int pn = u.pn;
        if (pn >= 14 && pn < 20) {
            const int isk = pn >= 17 ? 1 : 0; const int head = 4 * (pn - 14 - 3 * isk) + wc;
            bf16_t* dst = (bf16_t*)(ws + WS_AQ + (size_t)isk * (WS_AK - WS_AQ)); const float* gain = qgain + (kgain - qgain) * isk;
            const float post = isk ? 1.0f : 0.125f * 1.4426950408889634f;
            f32x4 gv[2][2];
#pragma unroll
            for (int bj = 0; bj < 2; ++bj)
#pragma unroll
                for (int n = 0; n < 2; ++n) gv[bj][n] = *(const f32x4*)(gain + bj * 32 + 8 * fq + 4 * n) * post;
#pragma unroll
            for (int ai = 0; ai < 2; ++ai)
#pragma unroll
                for (int m = 0; m < 4; ++m) {
                    const int row = row0 + ai * HALF + m * 16; const float s = scale_of(P.v[4 * ai + m]); float q = 0.f; f32x4 v[2][2];
#pragma unroll
                    for (int bj = 0; bj < 2; ++bj)
#pragma unroll
                        for (int n = 0; n < 2; ++n) { v[bj][n] = acc[ai][bj][m][n] * s; const f32x4 x = v[bj][n]; q += (x[0] * x[0] + x[1] * x[1]) + (x[2] * x[2] + x[3] * x[3]); }
                    q += __shfl_xor(q, 16); q += __shfl_xor(q, 32);
                    const float rn = __builtin_amdgcn_rsqf(q * (1.0f / 64.0f) + 1e-6f);
#pragma unroll
                    for (int bj = 0; bj < 2; ++bj) { const int cc = head * 64 + bj * 32 + 8 * fq; st16(dst + (isk ? hm12(row, cc) : (size_t)row * 768 + cc), pack8(v[bj][0] * rn * gv[bj][0], v[bj][1] * rn * gv[bj][1])); }
                }
            return;
        }
        size_t boff; int ld, colt, lim;
        if (pn < 12) { boff = WS_PR + (size_t)(pn >> 2) * (WS_PK - WS_PR); ld = 1024; colt = (pn & 3) * 256; lim = 1 << 30; }
        else if (pn < 14) { boff = WS_LORA; ld = 288; colt = (pn - 12) * 256; lim = 288; }
        else { boff = WS_AV; ld = 768; colt = (pn - 20) * 256; lim = 1 << 30; }
        bf16_t* dst = (bf16_t*)(ws + boff);
        const int col0 = colt + wc * 32 + 8 * fq;
#pragma unroll
        for (int ai = 0; ai < 2; ++ai)
#pragma unroll
            for (int m = 0; m < 4; ++m) {
                const int row = row0 + ai * HALF + m * 16; const float s = scale_of(P.v[4 * ai + m]);
#pragma unroll
                for (int bj = 0; bj < 2; ++bj) { const int c = col0 + bj * HALF; if (c < lim) st16(dst + (pn < 12 ? hmoff(row, c) : pn >= 20 ? hm12(row, c) : (size_t)row * ld + c), pack8(acc[ai][bj][m][0] * s, acc[ai][bj][m][1] * s)); }
            }
    }
};

__device__ __forceinline__ size_t goff(int pm, int pn8, int ai, int m, int bj, int wr, int wc, int fr, int fq) {
    return ((((size_t)(pm * 8 + pn8) * 16 + (ai * 8 + m * 2 + bj)) * 512) + ((wr * 4 + wc) * 64 + fq * 16 + fr)) * 8; }
struct EpiGates {
    static constexpr bool PERM = true, AFTER_DRAIN = false, TWICE_OK = true; static constexpr bool Z64 = true;
    typedef PreRows Pre;
    bf16_t* G; const float* ss; const float* bgate;
    __device__ __forceinline__ void pre(const Unit& u, int wr, int fr, Pre& P) const { load_rows_ss(ss, u, wr, fr, P); }
    __device__ __forceinline__ void operator()(const f32x4 (&acc)[2][2][4][2], const Unit& u, int wr, int wc, int fr, int fq, const Pre& P) const {
        const int row0 = u.pm * BM + wr * 64 + fr, col0 = u.pn * BM + wc * 32 + 8 * fq;
        f32x4 bv[2][2];
#pragma unroll
        for (int bj = 0; bj < 2; ++bj)
#pragma unroll
            for (int n = 0; n < 2; ++n) bv[bj][n] = *(const f32x4*)(bgate + col0 + bj * HALF + 4 * n) * -1.4426950408889634f;
#pragma unroll
        for (int ai = 0; ai < 2; ++ai)
#pragma unroll
            for (int m = 0; m < 4; ++m) {
                const int row = row0 + ai * HALF + m * 16; const float s = scale_of(P.v[4 * ai + m]) * -1.4426950408889634f;
#pragma unroll
                for (int bj = 0; bj < 2; ++bj) { f32x4 o[2];
#pragma unroll
                    for (int n = 0; n < 2; ++n)
#pragma unroll
                        for (int i = 0; i < 4; ++i) o[n][i] = __builtin_amdgcn_rcpf(1.0f + __builtin_amdgcn_exp2f(acc[ai][bj][m][n][i] * s + bv[bj][n][i]));
                    st16(G + goff(u.pm, u.pn, ai, m, bj, wr, wc, fr, fq), pack8(o[0], o[1])); }
            }
    }
};

struct EpiGn {
    static constexpr bool PERM = true, AFTER_DRAIN = false, TWICE_OK = false; static constexpr bool Z64 = false;
    typedef PreNone Pre;
    bf16_t* wkv; const bf16_t* pv; const float* bonus; const PG8_LAS float* cl;
    __device__ __forceinline__ void pre(const Unit&, int, int, Pre&) const {}
    __device__ __forceinline__ void operator()(const f32x4 (&acc)[2][2][4][2], const Unit& u, int wr, int wc, int fr, int fq, const Pre&) const {
        const int row0 = u.pm * BM + wr * 64 + fr; const int head = 4 * u.pn + wc; const int cb = head * 64 + 8 * fq;
#pragma unroll
        for (int ai = 0; ai < 2; ++ai)
#pragma unroll
            for (int m = 0; m < 4; ++m) {
                int row = row0 + ai * HALF + m * 16; asm volatile("" : "+v"(row) :: "memory"); const bool hasprev = (row & 4095) != 0;
                u32x4 xr[2], vcr[2], vpr[2];
#pragma unroll
                for (int bj = 0; bj < 2; ++bj) { int cbo = cb + bj * 32; asm volatile("" : "+v"(cbo)); const size_t voff = hmoff(row, cbo);
                    xr[bj] = *(const u32x4*)(wkv + (size_t)row * 1024 + cbo); vcr[bj] = *(const u32x4*)(pv + voff);
                    vpr[bj] = (u32x4){0u, 0u, 0u, 0u}; if (hasprev) vpr[bj] = *(const u32x4*)(pv + voff - 64); }
                const float bon = bonus[(size_t)row * 16 + head];
                f32x4 x[2][2]; float s1 = 0.f;
#pragma unroll
                for (int bj = 0; bj < 2; ++bj) { unpack8(xr[bj], x[bj][0], x[bj][1]);
#pragma unroll
                    for (int n = 0; n < 2; ++n) s1 += (x[bj][n][0] + x[bj][n][1]) + (x[bj][n][2] + x[bj][n][3]); }
                s1 += __shfl_xor(s1, 16); s1 += __shfl_xor(s1, 32);
                const float mean = s1 * (1.0f / 64.0f); float s2 = 0.f;
#pragma unroll
                for (int bj = 0; bj < 2; ++bj)
#pragma unroll
                    for (int n = 0; n < 2; ++n) { x[bj][n] = x[bj][n] - mean; const f32x4 d = x[bj][n]; s2 += (d[0] * d[0] + d[1] * d[1]) + (d[2] * d[2] + d[3] * d[3]); }
                s2 += __shfl_xor(s2, 16); s2 += __shfl_xor(s2, 32);
                const float rstd = __builtin_amdgcn_rsqf(s2 * (1.0f / 64.0f) + 64e-5f);
#pragma unroll
                for (int bj = 0; bj < 2; ++bj) {
                    f32x4 vc[2], vp[2]; unpack8(vcr[bj], vc[0], vc[1]); unpack8(vpr[bj], vp[0], vp[1]);
                    f32x4 o[2];
#pragma unroll
                    for (int n = 0; n < 2; ++n) { const int c = cb + bj * 32 + 4 * n;
                        const f32x4 w__ = *(const PG8_LAS f32x4*)(cl + c), b_ = *(const PG8_LAS f32x4*)(cl + 1024 + c), mu_ = *(const PG8_LAS f32x4*)(cl + 2048 + c);
                        const f32x4 vs = vc[n] + (vp[n] - vc[n]) * mu_;
                        o[n] = (x[bj][n] * rstd * w__ + b_ + vs * bon) * acc[ai][bj][m][n]; }
                    st16(wkv + (size_t)row * 1024 + cb + bj * 32, pack8(o[0], o[1]));
                    asm volatile("" ::: "memory"); }
            }
    }
};

template <bool SECOND, int GH> struct EpiProj {
    static constexpr bool PERM = true, AFTER_DRAIN = false, TWICE_OK = !SECOND; static constexpr bool Z64 = true;
    typedef PreNone Pre;
    bf16_t* mg; const bf16_t* gates;
    __device__ __forceinline__ void pre(const Unit&, int, int, Pre&) const {}
    __device__ __forceinline__ void operator()(const f32x4 (&acc)[2][2][4][2], const Unit& u, int wr, int wc, int fr, int fq, const Pre&) const {
        const int row0 = u.pm * BM + wr * 64 + fr, col0 = u.pn * BM + wc * 32 + 8 * fq;
#pragma unroll
        for (int ai = 0; ai < 2; ++ai) {
            u32x4 gr[4][2], tr[4][2];
#pragma unroll
            for (int m = 0; m < 4; ++m)
#pragma unroll
                for (int bj = 0; bj < 2; ++bj) { gr[m][bj] = __builtin_nontemporal_load((const u32x4*)(gates + goff(u.pm, u.pn + 4 * GH, ai, m, bj, wr, wc, fr, fq)));
                    if (SECOND) tr[m][bj] = *(const u32x4*)(mg + boff(row0 + ai * HALF + m * 16, col0 + bj * HALF)); }
#pragma unroll
            for (int m = 0; m < 4; ++m) {
                const int row = row0 + ai * HALF + m * 16;
#pragma unroll
                for (int bj = 0; bj < 2; ++bj) {
                    f32x4 g0, g1; unpack8(gr[m][bj], g0, g1);
                    f32x4 o0 = g0 * acc[ai][bj][m][0], o1 = g1 * acc[ai][bj][m][1];
                    if (SECOND) { f32x4 t0, t1; unpack8(tr[m][bj], t0, t1); o0 += t0; o1 += t1; }
                    st16(mg + boff(row, col0 + bj * HALF), pack8(o0, o1));
                }
            }
        }
    }
};
typedef double f64x2_ __attribute__((ext_vector_type(2)));
template <class Epi, class Sched, bool ALIGN_EPI = false, bool SP2 = false>
__device__ __forceinline__ void gemm_phase(PG8_LAS unsigned char* lds, const Gemm g, const Sched& S, const Epi& E) {
    int tid_ = threadIdx.x; asm volatile("" : "+v"(tid_));
    const int tid = tid_, wid = __builtin_amdgcn_readfirstlane(tid >> 6), lane = tid & 63, wr = wid >> 2, wc = wid & 3, fr = lane & 15, fq = lane >> 4;
    const int K = g.K, nt = K / BK;
#ifdef STATIC_PRIO
    if (wid >= 4) __builtin_amdgcn_s_setprio(1);
#endif
    unsigned voffA[2], voffB[2];
#pragma unroll
    for (int i = 0; i < 2; ++i) { int R, C; stage_rc(tid * 16 + i * 8192, R, C); const int Rb = Epi::PERM ? ((R & ~31) + perm32(R & 31)) : R;
        const int ldA = (g.blk & 1) ? BK : K, ldB = (g.blk & 2) ? BK : K;
        voffA[i] = (unsigned)(R * ldA + C) * 2u; voffB[i] = (unsigned)(Rb * ldB + C) * 2u; }
    const size_t kstepA = (g.blk & 1) ? (size_t)(BM * BK * 2) : (size_t)(BK * 2), kstepB = (g.blk & 2) ? (size_t)(BM * BK * 2) : (size_t)(BK * 2);
    const size_t hstepA = (g.blk & 1) ? (size_t)(HALF * BK * 2) : (size_t)HALF * K * 2, hstepB = (g.blk & 2) ? (size_t)(HALF * BK * 2) : (size_t)HALF * K * 2;
    const size_t tstep = (size_t)BM * K * 2;
    const unsigned ldsw = (unsigned)wid * 1024u;
    const int aoff = lds_byte(wr * 64 + fr, fq * 8), boff = lds_byte(wc * 32 + fr, fq * 8);
#define PG8_SA(b, h) (((b) * 2 + (h)) * HTB)
#define PG8_SB(b, h) ((4 + (b) * 2 + (h)) * HTB)
#define PG8_STAGE(bufoff, gbase, voff) do { _Pragma("unroll") for (int _i = 0; _i < 2; ++_i) \
        __builtin_amdgcn_global_load_lds((const unsigned*)((const char*)(gbase) + (voff)[_i]), (PG8_LAS unsigned*)(lds + (bufoff) + ldsw + _i * 8192), 16, 0, 0); } while (0)
#define PG8_LDA(dst, b, h) do { _Pragma("unroll") for (int m = 0; m < 4; ++m) _Pragma("unroll") for (int k = 0; k < 2; ++k) dst[m][k] = *(const PG8_LAS bf16x8*)(lds + PG8_SA(b, h) + aoff + m * 2048 + k * 1024); } while (0)
#define PG8_LDB(dst, b, h) do { _Pragma("unroll") for (int n = 0; n < 2; ++n) _Pragma("unroll") for (int k = 0; k < 2; ++k) dst[n][k] = *(const PG8_LAS bf16x8*)(lds + PG8_SB(b, h) + boff + n * 2048 + k * 1024); } while (0)
#ifdef STATIC_PRIO
#define PG8_PRIO1()
#define PG8_PRIO0()
#else
#define PG8_PRIO1() __builtin_amdgcn_s_setprio(1)
#define PG8_PRIO0() __builtin_amdgcn_s_setprio(0)
#endif
#define PG8_MMA(ai, bj, At, Bt) do { PG8_PRIO1(); _Pragma("unroll") for (int m = 0; m < 4; ++m) _Pragma("unroll") for (int n = 0; n < 2; ++n) _Pragma("unroll") for (int k = 0; k < 2; ++k) \
        acc[ai][bj][m][n] = __builtin_amdgcn_mfma_f32_16x16x32_bf16(Bt[n][k], At[m][k], acc[ai][bj][m][n], 0, 0, 0); PG8_PRIO0(); } while (0)
#define PG8_MMA_Z(ai, bj, At, Bt) do { PG8_PRIO1(); _Pragma("unroll") for (int m = 0; m < 4; ++m) _Pragma("unroll") for (int n = 0; n < 2; ++n) { \
        acc[ai][bj][m][n] = __builtin_amdgcn_mfma_f32_16x16x32_bf16(Bt[n][0], At[m][0], (f32x4){0.f, 0.f, 0.f, 0.f}, 0, 0, 0); \
        acc[ai][bj][m][n] = __builtin_amdgcn_mfma_f32_16x16x32_bf16(Bt[n][1], At[m][1], acc[ai][bj][m][n], 0, 0, 0); } PG8_PRIO0(); } while (0)
#define PG8_WAIT_V(n) asm volatile("s_waitcnt vmcnt(" #n ")" ::: "memory")
#define PG8_WAIT_L(n) asm volatile("s_waitcnt lgkmcnt(" #n ")" ::: "memory")
#define PG8_BAR __builtin_amdgcn_s_barrier()
#define PG8_SCHED __builtin_amdgcn_sched_barrier(0)
    Unit cur, nxt; int ui = 0;
    if (!S.next(0, cur)) return;
    f32x4 acc[2][2][4][2];
#ifndef ZERO_C
#pragma unroll
    for (int a = 0; a < 2; ++a)
#pragma unroll
        for (int b = 0; b < 2; ++b)
#pragma unroll
            for (int m = 0; m < 4; ++m)
#pragma unroll
                for (int n = 0; n < 2; ++n) { if constexpr (Epi::Z64) { double z0_, z1_; asm volatile("v_mov_b64 %0, 0" : "=v"(z0_)); asm volatile("v_mov_b64 %0, 0" : "=v"(z1_)); acc[a][b][m][n] = __builtin_bit_cast(f32x4, ((f64x2_){z0_, z1_})); } else acc[a][b][m][n] = (f32x4){0.f, 0.f, 0.f, 0.f}; }
#endif
    bf16x8 At[4][2], B0[2][2], B1[2][2];
    const char* cA = (const char*)g.A + (size_t)cur.pm * tstep; const char* cB = (const char*)g.Bt + (size_t)cur.pn * tstep;
    S.a_ready(cur);
    typename Epi::Pre pre_; E.pre(cur, wr, fr, pre_);
    if constexpr (SP2) {
        PG8_STAGE(PG8_SB(0, 0), cB, voffB); PG8_STAGE(PG8_SB(0, 1), cB + hstepB, voffB); PG8_STAGE(PG8_SA(0, 0), cA, voffA); PG8_STAGE(PG8_SA(0, 1), cA + hstepA, voffA);
        if (wr == 1) PG8_BAR;
        PG8_WAIT_V(2); PG8_BAR;
        PG8_STAGE(PG8_SB(1, 0), cB + kstepB, voffB); PG8_STAGE(PG8_SA(1, 0), cA + kstepA, voffA); PG8_STAGE(PG8_SB(1, 1), cB + hstepB + kstepB, voffB);
        PG8_WAIT_V(6); PG8_BAR;
    } else {
        PG8_STAGE(PG8_SB(0, 0), cB, voffB); PG8_STAGE(PG8_SA(0, 0), cA, voffA); PG8_STAGE(PG8_SB(0, 1), cB + hstepB, voffB); PG8_STAGE(PG8_SA(0, 1), cA + hstepA, voffA);
        if (wr == 1) PG8_BAR;
        PG8_WAIT_V(4); PG8_BAR;
        PG8_STAGE(PG8_SB(1, 0), cB + kstepB, voffB); PG8_STAGE(PG8_SA(1, 0), cA + kstepA, voffA); PG8_STAGE(PG8_SB(1, 1), cB + hstepB + kstepB, voffB);
        PG8_WAIT_V(6); PG8_BAR;
    }
    for (;;) {
        const bool has_next = S.next(ui + 1, nxt);
        const char* nA = has_next ? (const char*)g.A + (size_t)nxt.pm * tstep : cA; const char* nB = has_next ? (const char*)g.Bt + (size_t)nxt.pn * tstep : cB;
#ifdef ZERO_C
        if constexpr (SP2) {
            const int t = 0; const bool last = (nt == 2);
            const char* a1 = cA + (size_t)(t + 1) * kstepA;
            const char* a2 = last ? nA : cA + (size_t)(t + 2) * kstepA; const char* b2 = last ? nB : cB + (size_t)(t + 2) * kstepB;
            const char* a3 = a2 + kstepA; const char* b3 = b2 + kstepB;
            if (last && has_next) S.a_ready(nxt);
            PG8_LDB(B0, 0, 0); PG8_LDB(B1, 0, 1); PG8_SCHED; PG8_LDA(At, 0, 0); PG8_STAGE(PG8_SA(1, 1), a1 + hstepA, voffA);
            PG8_WAIT_V(8); PG8_WAIT_L(0); PG8_BAR; PG8_MMA_Z(0, 0, At, B0); PG8_MMA_Z(0, 1, At, B1); PG8_BAR; PG8_SCHED;
            PG8_LDA(At, 0, 1); PG8_STAGE(PG8_SB(0, 0), b2, voffB); PG8_STAGE(PG8_SB(0, 1), b2 + hstepB, voffB); PG8_STAGE(PG8_SA(0, 0), a2, voffA);
            PG8_WAIT_V(8); PG8_WAIT_L(0); PG8_BAR; PG8_MMA_Z(1, 0, At, B0); PG8_MMA_Z(1, 1, At, B1); PG8_BAR; PG8_SCHED;
            PG8_LDB(B0, 1, 0); PG8_LDB(B1, 1, 1); PG8_SCHED; PG8_LDA(At, 1, 0); PG8_STAGE(PG8_SA(0, 1), a2 + hstepA, voffA);
            PG8_WAIT_V(8); PG8_WAIT_L(0); PG8_BAR; PG8_MMA(0, 0, At, B0); PG8_MMA(0, 1, At, B1); PG8_BAR; PG8_SCHED;
            PG8_LDA(At, 1, 1); PG8_STAGE(PG8_SB(1, 0), b3, voffB); PG8_STAGE(PG8_SB(1, 1), b3 + hstepB, voffB); PG8_STAGE(PG8_SA(1, 0), a3, voffA);
            PG8_WAIT_V(8); PG8_WAIT_L(0); PG8_BAR; PG8_MMA(1, 0, At, B0); PG8_MMA(1, 1, At, B1); PG8_BAR; PG8_SCHED;
        }
        for (int t = (SP2 ? 2 : 0); t < nt; t += 2) {
#else
        for (int t = 0; t < nt; t += 2) {
#endif
            const bool last = (t == nt - 2);
            const char* a1 = cA + (size_t)(t + 1) * kstepA;
            const char* a2 = last ? nA : cA + (size_t)(t + 2) * kstepA; const char* b2 = last ? nB : cB + (size_t)(t + 2) * kstepB;
            const char* a3 = a2 + kstepA; const char* b3 = b2 + kstepB;
            if (last && has_next) S.a_ready(nxt);
            if constexpr (SP2) {
            PG8_LDB(B0, 0, 0); PG8_LDB(B1, 0, 1); PG8_SCHED; PG8_LDA(At, 0, 0); PG8_STAGE(PG8_SA(1, 1), a1 + hstepA, voffA);
            PG8_WAIT_V(8); PG8_WAIT_L(0); PG8_BAR; PG8_MMA(0, 0, At, B0); PG8_MMA(0, 1, At, B1); PG8_BAR; PG8_SCHED;
            PG8_LDA(At, 0, 1); PG8_STAGE(PG8_SB(0, 0), b2, voffB); PG8_STAGE(PG8_SB(0, 1), b2 + hstepB, voffB); PG8_STAGE(PG8_SA(0, 0), a2, voffA);
            PG8_WAIT_V(8); PG8_WAIT_L(0); PG8_BAR; PG8_MMA(1, 0, At, B0); PG8_MMA(1, 1, At, B1); PG8_BAR; PG8_SCHED;
            PG8_LDB(B0, 1, 0); PG8_LDB(B1, 1, 1); PG8_SCHED; PG8_LDA(At, 1, 0); PG8_STAGE(PG8_SA(0, 1), a2 + hstepA, voffA);
            PG8_WAIT_V(8); PG8_WAIT_L(0); PG8_BAR; PG8_MMA(0, 0, At, B0); PG8_MMA(0, 1, At, B1); PG8_BAR; PG8_SCHED;
            PG8_LDA(At, 1, 1); PG8_STAGE(PG8_SB(1, 0), b3, voffB); PG8_STAGE(PG8_SB(1, 1), b3 + hstepB, voffB); PG8_STAGE(PG8_SA(1, 0), a3, voffA);
            PG8_WAIT_V(8); PG8_WAIT_L(0); PG8_BAR; PG8_MMA(1, 0, At, B0); PG8_MMA(1, 1, At, B1); PG8_BAR; PG8_SCHED;
            } else {
            PG8_LDB(B0, 0, 0); PG8_SCHED; PG8_LDA(At, 0, 0); PG8_STAGE(PG8_SA(1, 1), a1 + hstepA, voffA);
            PG8_WAIT_L(8); PG8_BAR; PG8_WAIT_L(0); PG8_MMA(0, 0, At, B0); PG8_BAR; PG8_SCHED;
            PG8_LDB(B1, 0, 1); PG8_STAGE(PG8_SB(0, 0), b2, voffB);
            PG8_BAR; PG8_WAIT_L(0); PG8_MMA(0, 1, At, B1); PG8_BAR;
            PG8_LDA(At, 0, 1); PG8_STAGE(PG8_SA(0, 0), a2, voffA);
            PG8_BAR; PG8_WAIT_L(0); PG8_MMA(1, 0, At, B0); PG8_BAR; PG8_SCHED;
            PG8_STAGE(PG8_SB(0, 1), b2 + hstepB, voffB);
            PG8_WAIT_V(6); PG8_BAR; PG8_MMA(1, 1, At, B1); PG8_BAR;
            PG8_LDB(B0, 1, 0); PG8_SCHED; PG8_LDA(At, 1, 0); PG8_STAGE(PG8_SA(0, 1), a2 + hstepA, voffA);
            PG8_WAIT_L(8); PG8_BAR; PG8_WAIT_L(0); PG8_MMA(0, 0, At, B0); PG8_BAR; PG8_SCHED;
            PG8_LDB(B1, 1, 1); PG8_STAGE(PG8_SB(1, 0), b3, voffB);
            PG8_BAR; PG8_WAIT_L(0); PG8_MMA(0, 1, At, B1); PG8_BAR;
            PG8_LDA(At, 1, 1); PG8_STAGE(PG8_SA(1, 0), a3, voffA);
            PG8_BAR; PG8_WAIT_L(0); PG8_MMA(1, 0, At, B0); PG8_BAR; PG8_SCHED;
            PG8_STAGE(PG8_SB(1, 1), b3 + hstepB, voffB);
            PG8_WAIT_V(6); PG8_BAR; PG8_MMA(1, 1, At, B1); PG8_BAR;
            }
        }
        if constexpr (ALIGN_EPI) { if (wr == 0) PG8_BAR; }
        if constexpr (!Epi::AFTER_DRAIN) { S.pre_store(cur); E(acc, cur, wr, wc, fr, fq, pre_);
#ifdef EPI_TWICE
            if constexpr (Epi::TWICE_OK) { asm volatile("" ::: "memory"); E(acc, cur, wr, wc, fr, fq, pre_); }
#endif
            S.done(cur); }
        if (!has_next) break;
#ifndef ZERO_C
#pragma unroll
        for (int a = 0; a < 2; ++a)
#pragma unroll
            for (int b = 0; b < 2; ++b)
#pragma unroll
                for (int m = 0; m < 4; ++m)
#pragma unroll
                    for (int n = 0; n < 2; ++n) { if constexpr (Epi::Z64) { double z0_, z1_; asm volatile("v_mov_b64 %0, 0" : "=v"(z0_)); asm volatile("v_mov_b64 %0, 0" : "=v"(z1_)); acc[a][b][m][n] = __builtin_bit_cast(f32x4, ((f64x2_){z0_, z1_})); } else acc[a][b][m][n] = (f32x4){0.f, 0.f, 0.f, 0.f}; }
#endif
        cur = nxt; cA = nA; cB = nB; ++ui; E.pre(cur, wr, fr, pre_);
        if constexpr (ALIGN_EPI) { if (wr == 1) PG8_BAR; }
    }
#ifdef STATIC_PRIO
    __builtin_amdgcn_s_setprio(0);
#endif
    PG8_WAIT_V(0);
    if constexpr (!ALIGN_EPI) { if (wr == 0) PG8_BAR; }
    PG8_BAR;
    if constexpr (Epi::AFTER_DRAIN) { S.pre_store(cur); E.fused(acc, cur, wr, wc, fr, fq, lds, wid, lane); S.done(cur); }
#undef PG8_SA
#undef PG8_SB
#undef PG8_STAGE
#undef PG8_LDA
#undef PG8_LDB
#undef PG8_MMA
#undef PG8_MMA_Z
#undef PG8_WAIT_V
#undef PG8_WAIT_L
#undef PG8_BAR
#undef PG8_SCHED
}
}
#define GAS __attribute__((address_space(1)))
#define LAS __attribute__((address_space(3)))
typedef unsigned short bf16;
typedef unsigned v4u __attribute__((ext_vector_type(4)));
typedef float f32x4 __attribute__((ext_vector_type(4)));
typedef short bf16x8 __attribute__((ext_vector_type(8)));
typedef GAS unsigned gu32;
typedef GAS unsigned long long gu64;
#define RLX_AGENT __ATOMIC_RELAXED, __HIP_MEMORY_SCOPE_AGENT
#define LDS_WAIT() asm volatile("s_waitcnt lgkmcnt(0)" ::: "memory")
#define VM_WAIT() asm volatile("s_waitcnt vmcnt(0)" ::: "memory")
__device__ __forceinline__ unsigned long long rt() { return __builtin_amdgcn_s_memrealtime(); }
__device__ __forceinline__ unsigned f2bf(float f) { unsigned u = __builtin_bit_cast(unsigned, f); return (u + 0x7fffu + ((u >> 16) & 1u)) >> 16; }
__device__ __forceinline__ unsigned pk2(float lo, float hi) { return f2bf(lo) | (f2bf(hi) << 16); }
#define XB_TMO      128
#define XB_XCNT(j)  (256  + 64 * (j))
#define XB_XSUB(j)  (1280 + 64 * (j))
#define XB_XGEN(j)  (2304 + 64 * (j))
#define XB_TOP      3328
#define XB_TOPGEN   3392
#define XCD_BAR_WORDS 3456
#define XB_SPIN_CAP (1u << 18)

__device__ __forceinline__ unsigned xb_ld(unsigned* p)              { return __hip_atomic_load(p, __ATOMIC_RELAXED, __HIP_MEMORY_SCOPE_AGENT); }
__device__ __forceinline__ unsigned xb_add(unsigned* p, unsigned v) { return __hip_atomic_fetch_add(p, v, __ATOMIC_RELAXED, __HIP_MEMORY_SCOPE_AGENT); }
__device__ __forceinline__ unsigned xb_xcc_id() { return (unsigned)__builtin_amdgcn_s_getreg((3 << 11) | 20) & 0xFu; }
#define XB_SPIN(cond, bar) do { unsigned _sp = 0; while (cond) { __builtin_amdgcn_s_sleep(1); \
    if ((++_sp & 255u) == 0u) { if (xb_ld(&(bar)[XB_TMO])) break; if (_sp > XB_SPIN_CAP) { atomicAdd(&(bar)[XB_TMO], 1u); break; } } } } while (0)

struct XcdBarrier {
    unsigned* bar; unsigned x;
    volatile LAS unsigned* st;
};

__device__ __forceinline__ XcdBarrier xcd_barrier_post(unsigned* bar, volatile LAS unsigned* st) {
    XcdBarrier b; b.bar = bar; b.x = xb_xcc_id(); b.st = st;
    if (threadIdx.x == 0) (void)xb_add(&bar[XB_XCNT(b.x)], 1u);
    return b;
}
__device__ __forceinline__ void xcd_barrier_complete(unsigned* bar, unsigned x, unsigned& nloc, unsigned& nx) {
    const unsigned G = gridDim.x * gridDim.y * gridDim.z;
    unsigned sum, cnt, mine, sp = 0u;
    for (;;) {
        sum = 0u; cnt = 0u; mine = 0u;
#pragma unroll
        for (unsigned j = 0; j < 16; ++j) { const unsigned c = xb_ld(&bar[XB_XCNT(j)]); sum += c; cnt += (c > 0u) ? 1u : 0u; mine = (j == x) ? c : mine; }
        if (sum == G) break;
        __builtin_amdgcn_s_sleep(1);
        if ((++sp & 255u) == 0u) { if (xb_ld(&bar[XB_TMO])) break; if (sp > XB_SPIN_CAP) { atomicAdd(&bar[XB_TMO], 1u); break; } }
    }
    nloc = mine > 0u ? mine : 1u; nx = cnt > 0u ? cnt : 1u;
}

__device__ __forceinline__ void xcd_barrier(const XcdBarrier& b) {
    asm volatile("s_waitcnt vmcnt(0)" ::: "memory");
    __syncthreads();
    if (threadIdx.x == 0) {
        unsigned* bar = b.bar;
        __builtin_amdgcn_s_waitcnt(0);
        unsigned nloc = b.st[0], nx = b.st[1];
        if (nloc == 0u) { xcd_barrier_complete(bar, b.x, nloc, nx); b.st[0] = nloc; b.st[1] = nx; }
        const unsigned old = xb_add(&bar[XB_XSUB(b.x)], 1u);
        const unsigned gen = old / nloc;
        if (old + 1u == (gen + 1u) * nloc) {
            __builtin_amdgcn_fence(__ATOMIC_RELEASE, "agent");
            asm volatile("s_waitcnt vmcnt(0)" ::: "memory");
            const unsigned og = xb_add(&bar[XB_TOP], 1u);
            const unsigned tg = og / nx;
            if (og + 1u == (tg + 1u) * nx) xb_add(&bar[XB_TOPGEN], 1u);
            else XB_SPIN(xb_ld(&bar[XB_TOPGEN]) == tg, bar);
            __builtin_amdgcn_fence(__ATOMIC_ACQUIRE, "agent");
            xb_add(&bar[XB_XGEN(b.x)], 1u);
            asm volatile("s_waitcnt vmcnt(0)" ::: "memory");
        } else {
            XB_SPIN(xb_ld(&bar[XB_XGEN(b.x)]) == gen, bar);
            __builtin_amdgcn_fence(__ATOMIC_ACQUIRE, "agent");
            asm volatile("s_waitcnt vmcnt(0)" ::: "memory");
        }
    }
    __syncthreads();
}
struct Frame {
    LAS unsigned char* lds;
    volatile LAS unsigned* MISC;
    gu32* ctl;
    int tid, lane, wave;
    int vcu, G;
};
__device__ __forceinline__ float wave_sum(float v) {
#pragma unroll
    for (int o = 1; o < 64; o <<= 1) v += __shfl_xor(v, o);
    return v;
}
__device__ __forceinline__ float bf_lo(unsigned w) { return __uint_as_float(w << 16); }
__device__ __forceinline__ float bf_hi(unsigned w) { return __uint_as_float(w & 0xffff0000u); }
__device__ __forceinline__ float fsigmoid(float x) { return __builtin_amdgcn_rcpf(1.0f + __expf(-x)); }

__device__ __forceinline__ void p0_item(const float* W, int Ksrc, int Nsrc, int scol, const float* gain, bf16* WT, int Kd, int drow, int k0, LAS float* scr, int lane, bool blk = false, float mul = 1.0f) {
    float v[32];
    const bool ok = scol >= 0;
    const float* src = W + (size_t)(k0 + (lane >> 5)) * Nsrc + (ok ? scol : 0) + (lane & 31);
#pragma unroll
    for (int i = 0; i < 32; ++i) { const int kg = k0 + 2 * i + (lane >> 5); v[i] = (ok && kg < Ksrc) ? __builtin_nontemporal_load(src + (size_t)(2 * i) * Nsrc) : 0.f; }
#pragma unroll
    for (int i = 0; i < 32; ++i) scr[(2 * i + (lane >> 5)) * 33 + (lane & 31)] = v[i];
    LDS_WAIT(); asm volatile("" ::: "memory");
    const int c = lane & 7;
    f32x4 g0 = (f32x4){1.f, 1.f, 1.f, 1.f}, g1 = g0;
    if (gain) { g0 = *(const f32x4*)(gain + k0 + 8 * c); g1 = *(const f32x4*)(gain + k0 + 8 * c + 4); }
    g0 *= mul; g1 *= mul;
#pragma unroll
    for (int j = 0; j < 4; ++j) { const int n = (lane >> 3) + 8 * j; const LAS float* s = scr + (8 * c) * 33 + n;
        v4u o; o.x = pk2(s[0 * 33] * g0[0], s[1 * 33] * g0[1]); o.y = pk2(s[2 * 33] * g0[2], s[3 * 33] * g0[3]); o.z = pk2(s[4 * 33] * g1[0], s[5 * 33] * g1[1]); o.w = pk2(s[6 * 33] * g1[2], s[7 * 33] * g1[3]);
        const int dr = drow + n;
        bf16* dst = blk ? WT + (size_t)(dr >> 8) * ((size_t)256 * Kd) + (size_t)(k0 >> 6) * (256 * 64) + (dr & 255) * 64 + 8 * c
                        : WT + (size_t)dr * Kd + k0 + 8 * c;
        *(GAS v4u*)dst = o; }
    LDS_WAIT(); asm volatile("" ::: "memory");
}
__device__ __forceinline__ int map_ffn_in(int db) { const int n = 32 * db, pn = n >> 8, bj = (n >> 7) & 1, jj = n & 127; return bj * FF + 128 * pn + jj; }
__device__ __forceinline__ int map_mix(int db) {
    const int pn = db >> 3, w = db & 7, bj = w >> 2, wc = w & 3;
    if (pn < 12) return 256 * pn + 32 * w;
    if (pn < 14) { const int c = (pn - 12) * 256 + 32 * w; return c < 288 ? 3072 + c : -1; }
    if (pn < 20) { const int isk = (pn - 14) / 3, tt = (pn - 14) % 3; return RW_COLS + isk * AW + (4 * tt + wc) * 64 + bj * 32; }
    return RW_COLS + 2 * AW + (pn - 20) * 256 + 32 * w;
}
__device__ __forceinline__ int map_g2(int db) { const int pn = db >> 3, w = db & 7, bj = w >> 2, wc = w & 3; return (4 * pn + wc) * 64 + bj * 32; }

struct P0Args { const float* in[26]; unsigned char* ws; float* out; };
__device__ __forceinline__ void p0_prologue(Frame& F, const P0Args& A, int part, int gw, int NGW) {
    LAS float* scr = (LAS float*)(F.lds + RING_OFF + F.wave * 16384);
    unsigned char* ws = A.ws;
    constexpr int J_W1 = 176 * 16, J_W2 = 32 * 44, J_WIN = 184 * 16, J_WG = 64 * 16, J_WA = 32 * 16, J_WB = 32 * 12, J_WO = 32 * 16, J_G2 = 32 * 4, J_L2 = 32 * 1;
    if (part == 1) {
        for (int it = gw; it < J_W1 + J_W2; it += NGW) {
            int r = it;
            if (r < J_W1) { const int db = r % 176, kb = r / 176; p0_item(A.in[24], D, 2 * FF, map_ffn_in(db), A.in[23], (bf16*)(ws + WS_W3T), D, 32 * db, 64 * kb, scr, F.lane, true); continue; } r -= J_W1;
            { const int db = r % 32, kb = r / 32; p0_item(A.in[25], FF, D, 32 * db, nullptr, (bf16*)(ws + WS_W4T), FF, 32 * db, 64 * kb, scr, F.lane, true); }
        }
        return;
    }
    constexpr int NITEMS = J_W1 + J_W2 + J_WIN + J_WG + J_WA + J_WB + J_WO + J_G2 + 2 * J_L2;
    for (int it = gw; it < NITEMS; it += NGW) {
        int r = it;
        if (r < J_W1) { const int db = r % 176, kb = r / 176; p0_item(A.in[2], D, 2 * FF, map_ffn_in(db), A.in[1], (bf16*)(ws + WS_W1T), D, 32 * db, 64 * kb, scr, F.lane, true); continue; } r -= J_W1;
        if (r < J_W2) { const int db = r % 32, kb = r / 32; p0_item(A.in[3], FF, D, 32 * db, nullptr, (bf16*)(ws + WS_W2T), FF, 32 * db, 64 * kb, scr, F.lane, true); continue; } r -= J_W2;
        if (r < J_WIN) { const int db = r % 184, kb = r / 184; p0_item(A.in[5], D, IN_COLS, map_mix(db), A.in[4], (bf16*)(ws + WS_WIN), D, 32 * db, 64 * kb, scr, F.lane, true); continue; } r -= J_WIN;
        if (r < J_WG) { const int db = r % 64, kb = r / 64; p0_item(A.in[5], D, IN_COLS, RW_COLS + 3 * AW + 32 * db, A.in[4], (bf16*)(ws + WS_WG), D, 32 * db, 64 * kb, scr, F.lane, true); continue; } r -= J_WG;
        if (r < J_WA) { const int db = r % 32, kb = r / 32; p0_item(A.in[20], D, D, 32 * db, nullptr, (bf16*)(ws + WS_WA), D, 32 * db, 64 * kb, scr, F.lane, true); continue; } r -= J_WA;
        if (r < J_WB) { const int db = r % 32, kb = r / 32; p0_item(A.in[21], AW, D, 32 * db, nullptr, (bf16*)(ws + WS_WB), AW, 32 * db, 64 * kb, scr, F.lane, true); continue; } r -= J_WB;
        if (r < J_WO) { const int db = r % 32, kb = r / 32; p0_item(A.in[22], D, D, 32 * db, nullptr, (bf16*)(ws + WS_WO), D, 32 * db, 64 * kb, scr, F.lane, true); continue; } r -= J_WO;
        if (r < J_G2) { const int db = r % 32, kb = r / 32; p0_item(A.in[12], 160, D, map_g2(db), nullptr, (bf16*)(ws + WS_G2T), 256, 32 * db, 64 * kb, scr, F.lane, true); continue; } r -= J_G2;
        if (r < J_L2) { p0_item(A.in[9], 64, D, 32 * r, nullptr, (bf16*)(ws + WS_L2T), 64, 32 * r, 0, scr, F.lane, false, -1.4426950408889634f); continue; }     r -= J_L2;
        p0_item(A.in[11], 64, D, 32 * r, nullptr, (bf16*)(ws + WS_L2T + 131072), 64, 32 * r, 0, scr, F.lane, false, -1.4426950408889634f);
    }
    bf16* xb0 = (bf16*)A.out; float* ss0 = (float*)(ws + WS_SS0); const float* x = A.in[0];
    constexpr int XR = 8;
    for (int m0 = gw; m0 < M; m0 += XR * NGW) {
        f32x4 v[XR][4]; float s[XR];
#pragma unroll
        for (int r = 0; r < XR; ++r) { const int m = (m0 + r * NGW < M) ? m0 + r * NGW : m0; const GAS f32x4* xr = (const GAS f32x4*)(x + (size_t)m * D) + F.lane;
#pragma unroll
            for (int j = 0; j < 4; ++j) v[r][j] = __builtin_nontemporal_load(xr + 64 * j); }
#pragma unroll
        for (int r = 0; r < XR; ++r) { s[r] = 0.f;
#pragma unroll
            for (int j = 0; j < 4; ++j) s[r] += (v[r][j].x * v[r][j].x + v[r][j].y * v[r][j].y) + (v[r][j].z * v[r][j].z + v[r][j].w * v[r][j].w);
            s[r] = wave_sum(s[r]); }
#pragma unroll
        for (int r = 0; r < XR; ++r) { const int m = m0 + r * NGW; if (m >= M) break;
            GAS unsigned long long* o8 = (GAS unsigned long long*)(xb0 + (size_t)(m >> 8) * (256 * D) + (size_t)(F.lane >> 4) * (256 * 64) + (m & 255) * 64 + 4 * (F.lane & 15));
#pragma unroll
            for (int j = 0; j < 4; ++j) o8[(size_t)j * (4 * 256 * 64 / 4)] = (unsigned long long)pk2(v[r][j].x, v[r][j].y) | ((unsigned long long)pk2(v[r][j].z, v[r][j].w) << 32);
            if (F.lane == 0) { ss0[m] = s[r]; ((float*)(ws + WS_SS1))[m] = 0.f; ((float*)(ws + WS_SS2))[m] = 0.f; }
        }
    }
}

typedef short v4i16_t __attribute__((ext_vector_type(4)));
typedef unsigned v2u __attribute__((ext_vector_type(2)));
__device__ __forceinline__ bf16x8 vtr2(const LAS unsigned char* p0, const LAS unsigned char* p1) {
    const v4i16_t a = __builtin_amdgcn_ds_read_tr16_b64_v4i16((LAS v4i16_t*)p0), b = __builtin_amdgcn_ds_read_tr16_b64_v4i16((LAS v4i16_t*)p1);
    return (bf16x8){a[0], a[1], a[2], a[3], b[0], b[1], b[2], b[3]};
}
constexpr int ATT_LDK = 144;
constexpr int ATT_V_OFF = 256 * ATT_LDK;
struct AttnRegs { v4u kv[4], vv[4]; bf16x8 qf0, qf1; };
#define ATT_DECODE(unit) const int b = (unit) / 384, rem = (unit) % 384, head = rem >> 5, idx = rem & 31; const int dsh = 2 * (head >> 2); const int nbs = 5 - dsh; const int c = idx >> nbs, n = idx & ((1 << nbs) - 1);
__device__ __forceinline__ void attn_load(Frame& F, int unit, const bf16* AQ, const bf16* AK, const bf16* AV, AttnRegs& R, int tid_, int lane_) {
    ATT_DECODE(unit)
    const int row = tid_ >> 1, hf = tid_ & 1; const int sp = (n - 1) * 128 + row;
    if (sp >= 0) {
        const size_t off = ((size_t)(b * NHA + head) * SEQ + ((size_t)sp << dsh) + c) * 64 + hf * 32;
        const GAS v4u* kp = (const GAS v4u*)(AK + off); const GAS v4u* vp = (const GAS v4u*)(AV + off);
#pragma unroll
        for (int i = 0; i < 4; ++i) { R.kv[i] = kp[i]; R.vv[i] = vp[i]; }
    } else {
#pragma unroll
        for (int i = 0; i < 4; ++i) { R.kv[i] = (v4u){0u, 0u, 0u, 0u}; R.vv[i] = R.kv[i]; }
    }
    const int l15 = lane_ & 15, gq = lane_ >> 4; const int qi = 16 * F.wave + l15; const size_t qtok = (size_t)b * SEQ + ((size_t)(n * 128 + qi) << dsh) + c;
    R.qf0 = *(const GAS bf16x8*)(AQ + qtok * AW + head * 64 + 8 * gq); R.qf1 = *(const GAS bf16x8*)(AQ + qtok * AW + head * 64 + 32 + 8 * gq);
}
__device__ __forceinline__ void attn_phase(Frame& F, int first, int step, int nunits, const bf16* AQ, const bf16* AK, const bf16* AV, bf16* O, float* LSE, bool do_store) {
    LAS unsigned char* Kl = F.lds + RING_OFF; LAS unsigned char* Vl = Kl + ATT_V_OFF;
    const int w = F.wave;
    if (first >= nunits) return;
    AttnRegs R; attn_load(F, first, AQ, AK, AV, R, F.tid, F.lane);
    for (int unit = first; unit < nunits; unit += step) {
        int tid = F.tid; asm volatile("" : "+v"(tid)); const int lane = tid & 63, l15 = lane & 15, gq = lane >> 4;
        ATT_DECODE(unit)
        { const int row = tid >> 1, hf = tid & 1;
#pragma unroll
          for (int i = 0; i < 4; ++i) { *(LAS v4u*)(Kl + row * ATT_LDK + hf * 64 + i * 16) = R.kv[i]; *(LAS v4u*)(Vl + row * ATT_LDK + hf * 64 + i * 16) = R.vv[i]; } }
        const bf16x8 qf0 = R.qf0, qf1 = R.qf1;
        const int qi = 16 * w + l15; const size_t qtok = (size_t)b * SEQ + ((size_t)(n * 128 + qi) << dsh) + c;
        __syncthreads();
        if (unit + step < nunits) attn_load(F, unit + step, AQ, AK, AV, R, tid, lane);
        f32x4 S[9];
#pragma unroll
        for (int kt = 0; kt < 9; ++kt) {
            const LAS unsigned char* kr = Kl + (16 * (w + kt) + l15) * ATT_LDK + 16 * gq;
            const bf16x8 k0 = *(const LAS bf16x8*)kr, k1 = *(const LAS bf16x8*)(kr + 64);
            f32x4 a = (f32x4){0.f, 0.f, 0.f, 0.f};
            a = __builtin_amdgcn_mfma_f32_16x16x32_bf16(k0, qf0, a, 0, 0, 0);
            a = __builtin_amdgcn_mfma_f32_16x16x32_bf16(k1, qf1, a, 0, 0, 0);
            S[kt] = a;
        }
        float mx = -1e30f;
#pragma unroll
        for (int kt = 0; kt < 9; ++kt)
#pragma unroll
            for (int r = 0; r < 4; ++r) { const int j = 16 * (w + kt) + 4 * gq + r; const int dist = qi + 128 - j;
                const bool ok = dist >= 0 && dist <= 128 && (n > 0 || j >= 128);
                S[kt][r] = ok ? S[kt][r] : -1e30f; mx = fmaxf(mx, S[kt][r]); }
        mx = fmaxf(mx, __shfl_xor(mx, 16)); mx = fmaxf(mx, __shfl_xor(mx, 32));
        float den = 0.f;
#pragma unroll
        for (int kt = 0; kt < 9; ++kt)
#pragma unroll
            for (int r = 0; r < 4; ++r) { const float p = __builtin_amdgcn_exp2f(S[kt][r] - mx); S[kt][r] = p; den += p; }
        den += __shfl_xor(den, 16); den += __shfl_xor(den, 32);
        f32x4 Oa[4];
#pragma unroll
        for (int et = 0; et < 4; ++et) Oa[et] = (f32x4){0.f, 0.f, 0.f, 0.f};
        const int q4 = l15 >> 2, p4 = l15 & 3;
#pragma unroll
        for (int pp = 0; pp < 5; ++pp) {
            const int kt0 = 2 * pp, kt1 = (pp < 4) ? 2 * pp + 1 : 8;
            const f32x4 Pa = S[kt0]; const f32x4 Pb = (pp < 4) ? S[kt1] : (f32x4){0.f, 0.f, 0.f, 0.f};
            v4u pw; pw.x = pg8::cvt_pk_bf16(Pa[0], Pa[1]); pw.y = pg8::cvt_pk_bf16(Pa[2], Pa[3]); pw.z = pg8::cvt_pk_bf16(Pb[0], Pb[1]); pw.w = pg8::cvt_pk_bf16(Pb[2], Pb[3]);
            const bf16x8 pb = __builtin_bit_cast(bf16x8, pw);
            const LAS unsigned char* v0 = Vl + (16 * (w + kt0) + 4 * gq + q4) * ATT_LDK + 8 * p4;
            const LAS unsigned char* v1 = Vl + (16 * (w + kt1) + 4 * gq + q4) * ATT_LDK + 8 * p4;
#pragma unroll
            for (int et = 0; et < 4; ++et) { const bf16x8 va = vtr2(v0 + 32 * et, v1 + 32 * et); Oa[et] = __builtin_amdgcn_mfma_f32_16x16x32_bf16(va, pb, Oa[et], 0, 0, 0); }
        }
        const float inv = 1.0f / den;
        bf16* op = O + qtok * AW + head * 64 + 4 * gq;
#pragma unroll
        for (int et = 0; et < 4; ++et) { const f32x4 o = Oa[et] * inv; unsigned long long w2 = (unsigned long long)pg8::cvt_pk_bf16(o[0], o[1]) | ((unsigned long long)pg8::cvt_pk_bf16(o[2], o[3]) << 32);
            if (do_store) *(GAS unsigned long long*)(op + 16 * et) = w2; else asm volatile("" :: "v"(w2)); }
        if (gq == 0 && do_store) LSE[qtok * NHA + head] = mx + __builtin_amdgcn_logf(den);
        __syncthreads();
    }
}

typedef float f32x2v __attribute__((ext_vector_type(2)));
struct ScanArgs { const bf16 *pr, *pk, *pv, *plora; const bf16* l2t; const float *mu, *w0, *a0, *kk, *ka, *rk; bf16* wkv; float* bonus; const bf16* twa; };
constexpr int S2_NP = 7, S2_C = 16, S2_NCH = SEQ / S2_C, S2_LD = 144;
constexpr int S2_AT = 0, S2_RT = 2304, S2_BH = 4608, S2_KH = 6912, S2_VT = 9216, S2_GC = 10240;
constexpr int S2_U0 = 10496, S2_Y0 = 12544;
constexpr int S2_REG = 14592;
constexpr int S2_VT1 = 14592, S2_U01 = 15616, S2_Y01 = 17664;
template <bool D> struct S2T { static constexpr int NP = D ? 6 : 7, REG = D ? 19712 : 14592, OFF_LW = NP * REG, OFF_CST = OFF_LW + 2 * 64 * 144, NCST = 704, OFF_FLG = OFF_CST + NCST * 4, END = OFF_FLG + 128, FIRSTP = D ? 2 : 1; };
static_assert(S2T<false>::END <= RING_BYTES && S2T<true>::END <= RING_BYTES, "scan2 LDS");
__device__ __forceinline__ bf16x8 frag_lo(const LAS unsigned char* p) { const v2u a = *(const LAS v2u*)p; v4u w = (v4u){a.x, a.y, 0u, 0u}; return __builtin_bit_cast(bf16x8, w); }
__device__ __forceinline__ bf16x8 frag_2(const LAS unsigned char* p0, const LAS unsigned char* p1) { const v2u a = *(const LAS v2u*)p0, b = *(const LAS v2u*)p1; v4u w = (v4u){a.x, a.y, b.x, b.y}; return __builtin_bit_cast(bf16x8, w); }
__device__ __forceinline__ bf16x8 frag_tr_lo(const LAS unsigned char* p) { const v4i16_t a = __builtin_amdgcn_ds_read_tr16_b64_v4i16((LAS v4i16_t*)p); return (bf16x8){a[0], a[1], a[2], a[3], 0, 0, 0, 0}; }
__device__ __forceinline__ bf16x8 pack_lo(const f32x4 a) { v4u w = (v4u){pg8::cvt_pk_bf16(a[0], a[1]), pg8::cvt_pk_bf16(a[2], a[3]), 0u, 0u}; return __builtin_bit_cast(bf16x8, w); }
__device__ __forceinline__ bf16x8 pack_2(const f32x4 a, const f32x4 b) { v4u w = (v4u){pg8::cvt_pk_bf16(a[0], a[1]), pg8::cvt_pk_bf16(a[2], a[3]), pg8::cvt_pk_bf16(b[0], b[1]), pg8::cvt_pk_bf16(b[2], b[3])}; return __builtin_bit_cast(bf16x8, w); }
__device__ __forceinline__ v2u pack4(const f32x4 a) { return (v2u){pg8::cvt_pk_bf16(a[0], a[1]), pg8::cvt_pk_bf16(a[2], a[3])}; }
#define S2_SHR(x, ctl) ((x) + __builtin_bit_cast(float, __builtin_amdgcn_update_dpp(0, __builtin_bit_cast(int, (x)), (ctl), 0xF, 0xF, true)))

struct S2Raw { v4u bw[2], ba[2]; v2u cr[4], ck[4], pr[4], pk[4]; v4u cv, pv, cv1, pv1; };
template <bool D>
__device__ __forceinline__ void scan2_load(const ScanArgs& A, int b, int h, int half, int c, int lane, S2Raw& R) {
    const int tt = lane & 15, g = lane >> 4; const int tseq = c * S2_C + tt; const size_t gt = (size_t)b * SEQ + tseq; const bool hp = tseq > 0;
    const v4u z4 = (v4u){0u, 0u, 0u, 0u}; const v2u z2 = (v2u){0u, 0u};
#pragma unroll
    for (int ks = 0; ks < 2; ++ks) { const int j0 = 8 * g + 32 * ks; R.bw[ks] = *(const GAS v4u*)(A.twa + gt * 128 + j0); R.ba[ks] = *(const GAS v4u*)(A.twa + gt * 128 + 64 + j0); }
    const size_t hm = ((size_t)(b * 16 + h) * SEQ + tseq) * 64;
#pragma unroll
    for (int nt = 0; nt < 4; ++nt) { const int c0 = 16 * nt + 4 * g;
        R.cr[nt] = *(const GAS v2u*)(A.pr + hm + c0); R.ck[nt] = *(const GAS v2u*)(A.pk + hm + c0); R.pr[nt] = z2; R.pk[nt] = z2;
        if (hp) { R.pr[nt] = *(const GAS v2u*)(A.pr + hm - 64 + c0); R.pk[nt] = *(const GAS v2u*)(A.pk + hm - 64 + c0); } }
    { const size_t off = hm + (D ? 0 : half * 32) + 8 * g; R.cv = *(const GAS v4u*)(A.pv + off); R.pv = z4; if (hp) R.pv = *(const GAS v4u*)(A.pv + off - 64);
      R.cv1 = z4; R.pv1 = z4; if (D) { R.cv1 = *(const GAS v4u*)(A.pv + off + 32); if (hp) R.pv1 = *(const GAS v4u*)(A.pv + off + 32 - 64); } }
}
template <bool D>
__device__ __forceinline__ void scan2_produce(Frame& F, const ScanArgs& A, int b, int h, int half, int c, LAS unsigned char* reg, volatile LAS unsigned* flg, int pidx, int lane, const S2Raw& R) {
    const int tt = lane & 15, g = lane >> 4; const int tseq = c * S2_C + tt; const size_t gt = (size_t)b * SEQ + tseq;
    const LAS float* cst = (const LAS float*)(F.lds + RING_OFF + S2T<D>::OFF_CST);
    const LAS unsigned char* lw = F.lds + RING_OFF + S2T<D>::OFF_LW;
    const int q4 = tt >> 2, p4 = tt & 3;
    bf16x8 bw[2], ba[2];
#pragma unroll
    for (int ks = 0; ks < 2; ++ks) { bw[ks] = __builtin_bit_cast(bf16x8, R.bw[ks]); ba[ks] = __builtin_bit_cast(bf16x8, R.ba[ks]); }
    v2u cr[4], ck[4], pr_[4], pk_[4];
#pragma unroll
    for (int nt = 0; nt < 4; ++nt) { cr[nt] = R.cr[nt]; ck[nt] = R.ck[nt]; pr_[nt] = R.pr[nt]; pk_[nt] = R.pk[nt]; }
    f32x4 accw[4], acca[4];
#pragma unroll
    for (int nt = 0; nt < 4; ++nt) {
        accw[nt] = (f32x4){0.f, 0.f, 0.f, 0.f}; acca[nt] = accw[nt];
#pragma unroll
        for (int ks = 0; ks < 2; ++ks) {
            const bf16x8 fw = *(const LAS bf16x8*)(lw + (16 * nt + tt) * 144 + (8 * g + 32 * ks) * 2);
            const bf16x8 fa = *(const LAS bf16x8*)(lw + 64 * 144 + (16 * nt + tt) * 144 + (8 * g + 32 * ks) * 2);
            accw[nt] = __builtin_amdgcn_mfma_f32_16x16x32_bf16(fw, bw[ks], accw[nt], 0, 0, 0);
            acca[nt] = __builtin_amdgcn_mfma_f32_16x16x32_bf16(fa, ba[ks], acca[nt], 0, 0, 0);
        }
    }
    float ssq = 0.f; float ksvv[4][4], kvv[4][4];
#pragma unroll
    for (int nt = 0; nt < 4; ++nt) { const int c0 = 16 * nt + 4 * g;
        const float kc[4] = {bf_lo(ck[nt].x), bf_hi(ck[nt].x), bf_lo(ck[nt].y), bf_hi(ck[nt].y)}, kp[4] = {bf_lo(pk_[nt].x), bf_hi(pk_[nt].x), bf_lo(pk_[nt].y), bf_hi(pk_[nt].y)};
#pragma unroll
        for (int i = 0; i < 4; ++i) { ksvv[nt][i] = kc[i] + (kp[i] - kc[i]) * cst[192 + c0 + i]; const float kv = ksvv[nt][i] * cst[416 + c0 + i]; kvv[nt][i] = kv; ssq += kv * kv; } }
    ssq += __shfl_xor(ssq, 16); ssq += __shfl_xor(ssq, 32);
    const float inv = 1.0f / fmaxf(sqrtf(ssq), 1e-12f);
    if (c >= S2T<D>::NP) { const unsigned want = (unsigned)(c - S2T<D>::NP + 1); while (flg[8 + pidx] != want) __builtin_amdgcn_s_sleep(1); if (D) while (flg[16 + pidx] != want) __builtin_amdgcn_s_sleep(1); }
    asm volatile("" ::: "memory");
    float bon = 0.f; f32x4 vrt4[4];
#pragma unroll
    for (int nt = 0; nt < 4; ++nt) {
        const int c0 = 16 * nt + 4 * g;
        const float rc[4] = {bf_lo(cr[nt].x), bf_hi(cr[nt].x), bf_lo(cr[nt].y), bf_hi(cr[nt].y)}, rp[4] = {bf_lo(pr_[nt].x), bf_hi(pr_[nt].x), bf_lo(pr_[nt].y), bf_hi(pr_[nt].y)};
        f32x4 vat, vbh, vkh, vrt, vgc;
#pragma unroll
        for (int i = 0; i < 4; ++i) {
            const int cc = c0 + i;
            const float rsv = rc[i] + (rp[i] - rc[i]) * cst[128 + cc];
            const float ksv = ksvv[nt][i];
            const float wl = cst[288 + cc] + accw[nt][i], al = cst[352 + cc] + acca[nt][i];
            const float av = __builtin_amdgcn_rcpf(1.0f + __builtin_amdgcn_exp2f(al));
            const float kn = kvv[nt][i] * inv; const float km = ksv * (cst[640 + cc] + av * cst[480 + cc]);
            const float ld = -0.8750387749145276f * __builtin_amdgcn_rcpf(1.0f + __builtin_amdgcn_exp2f(wl));
            float L = ld; L = S2_SHR(L, 0x111); L = S2_SHR(L, 0x112); L = S2_SHR(L, 0x114); L = S2_SHR(L, 0x118);
            const float eL = __builtin_amdgcn_exp2f(L), emL = __builtin_amdgcn_rcpf(eL);
            const float eLm = __builtin_bit_cast(float, __builtin_amdgcn_update_dpp(0x3f800000, __builtin_bit_cast(int, eL), 0x111, 0xF, 0xF, false));
            vat[i] = -kn * eLm; vbh[i] = kn * av * emL; vkh[i] = km * emL; vrt[i] = rsv * eL; vgc[i] = eL;
            bon += rsv * km * cst[544 + cc];
        }
        const int o = tt * S2_LD + c0 * 2;
        *(LAS v2u*)(reg + S2_AT + o) = pack4(vat); *(LAS v2u*)(reg + S2_BH + o) = pack4(vbh); *(LAS v2u*)(reg + S2_KH + o) = pack4(vkh); *(LAS v2u*)(reg + S2_RT + o) = pack4(vrt);
        if (tt == 15) *(LAS f32x4*)(reg + S2_GC + c0 * 4) = vgc;
        vrt4[nt] = vrt;
    }
    bon += __shfl_xor(bon, 16); bon += __shfl_xor(bon, 32);
    if ((D || half == 0) && g == 0) A.bonus[gt * 16 + h] = bon;
#pragma unroll
    for (int hf = 0; hf < (D ? 2 : 1); ++hf) {
        const v4u cv = hf ? R.cv1 : R.cv, pvv = hf ? R.pv1 : R.pv; const int mo = hf ? 608 : 256, vo = hf ? S2_VT1 : S2_VT;
#pragma unroll
        for (int e2 = 0; e2 < 4; ++e2) {
            float a0 = bf_lo(cv[e2]), a1 = bf_hi(cv[e2]);
            a0 += (bf_lo(pvv[e2]) - a0) * cst[mo + 8 * g + 2 * e2]; a1 += (bf_hi(pvv[e2]) - a1) * cst[mo + 8 * g + 2 * e2 + 1];
            *(LAS unsigned short*)(reg + vo + (8 * g + 2 * e2) * 32 + tt * 2) = (unsigned short)f2bf(a0);
            *(LAS unsigned short*)(reg + vo + (8 * g + 2 * e2 + 1) * 32 + tt * 2) = (unsigned short)f2bf(a1);
        }
    }
    f32x4 cab = (f32x4){0.f, 0.f, 0.f, 0.f}, cabT = cab, cakT = cab, crbT = cab, crkT = cab;
#pragma unroll
    for (int ks = 0; ks < 2; ++ks) {
        const int o = tt * S2_LD + (8 * g + 32 * ks) * 2;
        const bf16x8 fat = *(const LAS bf16x8*)(reg + S2_AT + o), frt = *(const LAS bf16x8*)(reg + S2_RT + o), fbh = *(const LAS bf16x8*)(reg + S2_BH + o), fkh = *(const LAS bf16x8*)(reg + S2_KH + o);
        cab = __builtin_amdgcn_mfma_f32_16x16x32_bf16(fat, fbh, cab, 0, 0, 0);
        cabT = __builtin_amdgcn_mfma_f32_16x16x32_bf16(fbh, fat, cabT, 0, 0, 0);
        cakT = __builtin_amdgcn_mfma_f32_16x16x32_bf16(fkh, fat, cakT, 0, 0, 0);
        crbT = __builtin_amdgcn_mfma_f32_16x16x32_bf16(fbh, frt, crbT, 0, 0, 0);
        crkT = __builtin_amdgcn_mfma_f32_16x16x32_bf16(fkh, frt, crkT, 0, 0, 0);
    }
    f32x4 idn;
#pragma unroll
    for (int r = 0; r < 4; ++r) { const int rr = 4 * g + r;
        cab[r] = (tt < rr) ? cab[r] : 0.f;
        cabT[r] = (rr < tt) ? cabT[r] : 0.f; cakT[r] = (rr < tt) ? cakT[r] : 0.f;
        crbT[r] = (rr <= tt) ? crbT[r] : 0.f; crkT[r] = (rr <= tt) ? crkT[r] : 0.f;
        idn[r] = (rr == tt) ? 1.f : 0.f; }
    bf16x8 fT;
    {
        const f32x4 z = (f32x4){0.f, 0.f, 0.f, 0.f};
        const bf16x8 a1b = pack_lo(cab), a1a = pack_lo(cabT);
        const f32x4 a2b = __builtin_amdgcn_mfma_f32_16x16x32_bf16(a1a, a1b, z, 0, 0, 0);
        const f32x4 a2a = __builtin_amdgcn_mfma_f32_16x16x32_bf16(a1b, a1a, z, 0, 0, 0);
        f32x4 ta = cabT + idn;
        const bf16x8 p2b = pack_lo(a2b), p2a = pack_lo(a2a);
        ta = __builtin_amdgcn_mfma_f32_16x16x32_bf16(p2b, pack_lo(ta), ta, 0, 0, 0);
        const f32x4 a4b = __builtin_amdgcn_mfma_f32_16x16x32_bf16(p2a, p2b, z, 0, 0, 0), a4a = __builtin_amdgcn_mfma_f32_16x16x32_bf16(p2b, p2a, z, 0, 0, 0);
        const bf16x8 p4b = pack_lo(a4b), p4a = pack_lo(a4a);
        ta = __builtin_amdgcn_mfma_f32_16x16x32_bf16(p4b, pack_lo(ta), ta, 0, 0, 0);
        const f32x4 a8b = __builtin_amdgcn_mfma_f32_16x16x32_bf16(p4a, p4b, z, 0, 0, 0);
        ta = __builtin_amdgcn_mfma_f32_16x16x32_bf16(pack_lo(a8b), pack_lo(ta), ta, 0, 0, 0);
        fT = pack_lo(ta);
    }
    const LAS unsigned char* trb = reg + (4 * g + q4) * S2_LD + 8 * p4;
    {
        bf16x8 fa[4];
#pragma unroll
        for (int kt = 0; kt < 4; ++kt) fa[kt] = frag_tr_lo(trb + S2_AT + 32 * kt);
#pragma unroll
        for (int kt = 0; kt < 4; ++kt) { f32x4 d = (f32x4){0.f, 0.f, 0.f, 0.f}; d = __builtin_amdgcn_mfma_f32_16x16x32_bf16(fa[kt], fT, d, 0, 0, 0);
            *(LAS v2u*)(reg + S2_AT + tt * S2_LD + (16 * kt + 4 * g) * 2) = pack4(d); }
    }
    {
        const bf16x8 fak = pack_lo(cakT);
        const bf16x8 frbk = pack_2(crbT, crkT);
#pragma unroll
        for (int hf = 0; hf < (D ? 2 : 1); ++hf) {
            const int vo = hf ? S2_VT1 : S2_VT, uo = hf ? S2_U01 : S2_U0, yo = hf ? S2_Y01 : S2_Y0;
#pragma unroll
            for (int vt = 0; vt < 2; ++vt) {
                const LAS unsigned char* vp = reg + vo + (16 * vt + tt) * 32 + 8 * g;
                f32x4 x = (f32x4){0.f, 0.f, 0.f, 0.f}; x = __builtin_amdgcn_mfma_f32_16x16x32_bf16(fak, frag_lo(vp), x, 0, 0, 0);
                f32x4 u0 = (f32x4){0.f, 0.f, 0.f, 0.f}; u0 = __builtin_amdgcn_mfma_f32_16x16x32_bf16(fT, pack_lo(x), u0, 0, 0, 0);
                *(LAS f32x4*)(reg + uo + (16 * vt + tt) * 64 + 16 * g) = u0;
                const v2u vv = *(const LAS v2u*)vp; const v2u uu = pack4(u0); v4u w = (v4u){uu.x, uu.y, vv.x, vv.y};
                f32x4 y0 = (f32x4){0.f, 0.f, 0.f, 0.f}; y0 = __builtin_amdgcn_mfma_f32_16x16x32_bf16(frbk, __builtin_bit_cast(bf16x8, w), y0, 0, 0, 0);
                *(LAS f32x4*)(reg + yo + (16 * vt + tt) * 64 + 16 * g) = y0;
            }
        }
    }
    {
        const bf16x8 frb = pack_lo(crbT);
        bf16x8 fa[4]; f32x4 ci[4];
#pragma unroll
        for (int kt = 0; kt < 4; ++kt) { fa[kt] = frag_tr_lo(trb + S2_AT + 32 * kt); ci[kt] = vrt4[kt]; }
#pragma unroll
        for (int kt = 0; kt < 4; ++kt) { const f32x4 d = __builtin_amdgcn_mfma_f32_16x16x32_bf16(fa[kt], frb, ci[kt], 0, 0, 0);
            *(LAS v2u*)(reg + S2_RT + tt * S2_LD + (16 * kt + 4 * g) * 2) = pack4(d); }
    }
    asm volatile("s_waitcnt lgkmcnt(0)" ::: "memory");
    if (lane == 0) flg[pidx] = (unsigned)(c + 1);
    asm volatile("" ::: "memory");
}

template <bool D>
__device__ __forceinline__ void scan2_stage(Frame& F, const ScanArgs& A, int unit) {
    const int h = D ? unit & 15 : (unit >> 1) & 15;
    LAS unsigned char* base = F.lds + RING_OFF;
    const int tid = F.tid;
    {
        LAS float* cst = (LAS float*)(base + S2T<D>::OFF_CST);
        const int half0 = D ? 0 : (unit & 1);
        for (int i = tid; i < S2T<D>::NCST; i += 512) {
            float v;
            if (i < 64) v = A.mu[3072 + i]; else if (i < 128) v = A.mu[3136 + (i - 64)]; else if (i < 192) v = A.mu[h * 64 + (i - 128)]; else if (i < 256) v = A.mu[1024 + h * 64 + (i - 192)];
            else if (i >= 640) v = 1.0f - A.ka[h * 64 + (i - 640)];
            else if (i >= 608) v = A.mu[2048 + h * 64 + 32 + (i - 608)];
            else if (i < 288) v = A.mu[2048 + h * 64 + half0 * 32 + (i - 256)]; else if (i < 352) v = -1.4426950408889634f * A.w0[h * 64 + (i - 288)]; else if (i < 416) v = -1.4426950408889634f * A.a0[h * 64 + (i - 352)];
            else if (i < 480) v = A.kk[h * 64 + (i - 416)]; else if (i < 544) v = A.ka[h * 64 + (i - 480)]; else v = A.rk[h * 64 + (i - 544)];
            cst[i] = v;
        }
        for (int i = tid; i < 1024; i += 512) { const int mat = i >> 9, rr = (i >> 3) & 63, ch = i & 7;
            const v4u v = *(const GAS v4u*)(A.l2t + (size_t)mat * 65536 + (size_t)(h * 64 + rr) * 64 + ch * 8);
            *(LAS v4u*)(base + S2T<D>::OFF_LW + mat * 64 * 144 + rr * 144 + ch * 16) = v; }
        if (tid < 32) ((LAS unsigned*)(base + S2T<D>::OFF_FLG))[tid] = 0u;
    }
}
template <bool D>
__device__ __forceinline__ void scan2_unit(Frame& F, const ScanArgs& A, int unit, bool staged = false, const gu32* guard = nullptr, unsigned gtarget = 0u) {
    const int b = D ? unit >> 4 : unit >> 5, h = D ? unit & 15 : (unit >> 1) & 15;
    constexpr int S2_NP_ = S2T<D>::NP, S2_REG_ = S2T<D>::REG;
    LAS unsigned char* base = F.lds + RING_OFF;
    const int tid = F.tid, lane = F.lane, w = F.wave;
    if (!staged) { scan2_stage<D>(F, A, unit); __syncthreads(); }
    volatile LAS unsigned* flg = (volatile LAS unsigned*)(base + S2T<D>::OFF_FLG);
    if (w >= S2T<D>::FIRSTP) {
        const int half = D ? 0 : (unit & 1);
        const int pidx = w - S2T<D>::FIRSTP; LAS unsigned char* reg = base + pidx * S2_REG_;
        S2Raw R; scan2_load<D>(A, b, h, half, pidx, lane, R);
        for (int c = pidx; c < S2_NCH; c += S2_NP_) { int lane_o = lane; asm volatile("" : "+v"(lane_o));
            S2Raw Rn; if (c + S2_NP_ < S2_NCH) scan2_load<D>(A, b, h, half, c + S2_NP_, lane_o, Rn); else Rn = R;
            scan2_produce<D>(F, A, b, h, half, c, reg, flg, pidx, lane_o, R); R = Rn; }
    } else {
        const int half = D ? w : (unit & 1);
        const int vo = (D && half) ? S2_VT1 : S2_VT, uo = (D && half) ? S2_U01 : S2_U0, yo = (D && half) ? S2_Y01 : S2_Y0, cf = (D && half) ? 16 : 8;
        f32x4 st[4][2];
        if (guard) { if (lane < 8) while (__hip_atomic_load(guard + 64 * lane, __ATOMIC_RELAXED, __HIP_MEMORY_SCOPE_AGENT) < gtarget) __builtin_amdgcn_s_sleep(1); asm volatile("" ::: "memory"); }
#pragma unroll
        for (int kt = 0; kt < 4; ++kt) { st[kt][0] = (f32x4){0.f, 0.f, 0.f, 0.f}; st[kt][1] = st[kt][0]; }
        for (int c = 0; c < S2_NCH; ++c) {
            int lane_o = lane; asm volatile("" : "+v"(lane_o));
            const int l15 = lane_o & 15, g = lane_o >> 4, q4 = l15 >> 2, p4 = l15 & 3;
            const int pidx = c % S2_NP_; const LAS unsigned char* reg = base + pidx * S2_REG_;
            { const unsigned want = (unsigned)(c + 1); while (flg[pidx] != want) __builtin_amdgcn_s_sleep(1); }
            asm volatile("" ::: "memory");
            f32x4 U[2], Y[2];
#pragma unroll
            for (int vt = 0; vt < 2; ++vt) { U[vt] = *(const LAS f32x4*)(reg + uo + (16 * vt + l15) * 64 + 16 * g); Y[vt] = *(const LAS f32x4*)(reg + yo + (16 * vt + l15) * 64 + 16 * g); }
#pragma unroll
            for (int ks = 0; ks < 2; ++ks) {
                const int o = l15 * S2_LD + (32 * ks + 4 * g) * 2;
                const bf16x8 fah = frag_2(reg + S2_AT + o, reg + S2_AT + o + 32), frh = frag_2(reg + S2_RT + o, reg + S2_RT + o + 32);
#pragma unroll
                for (int vt = 0; vt < 2; ++vt) { const bf16x8 sb = pack_2(st[2 * ks][vt], st[2 * ks + 1][vt]);
                    U[vt] = __builtin_amdgcn_mfma_f32_16x16x32_bf16(fah, sb, U[vt], 0, 0, 0); Y[vt] = __builtin_amdgcn_mfma_f32_16x16x32_bf16(frh, sb, Y[vt], 0, 0, 0); }
            }
            { bf16* yp = A.wkv + ((size_t)b * SEQ + (size_t)c * S2_C + 4 * g) * 1024 + h * 64 + half * 32 + l15;
#pragma unroll
              for (int vt = 0; vt < 2; ++vt)
#pragma unroll
                  for (int r = 0; r < 4; ++r) yp[(size_t)r * 1024 + 16 * vt] = (bf16)f2bf(Y[vt][r]); }
            bf16x8 ub[2];
#pragma unroll
            for (int vt = 0; vt < 2; ++vt) { const v2u uu = pack4(U[vt]); const v2u vv = *(const LAS v2u*)(reg + vo + (16 * vt + l15) * 32 + 8 * g); v4u wv = (v4u){uu.x, uu.y, vv.x, vv.y}; ub[vt] = __builtin_bit_cast(bf16x8, wv); }
            const LAS unsigned char* trb = reg + (4 * g + q4) * S2_LD + 8 * p4;
#pragma unroll
            for (int kt = 0; kt < 4; ++kt) {
                const bf16x8 fbk = vtr2(trb + S2_BH + 32 * kt, trb + S2_KH + 32 * kt);
                const f32x4 gc = *(const LAS f32x4*)(reg + S2_GC + (16 * kt + 4 * g) * 4);
#pragma unroll
                for (int vt = 0; vt < 2; ++vt) st[kt][vt] = __builtin_amdgcn_mfma_f32_16x16x32_bf16(fbk, ub[vt], st[kt][vt], 0, 0, 0) * gc;
            }
            asm volatile("s_waitcnt lgkmcnt(0)" ::: "memory");
            if (lane == 0) flg[cf + pidx] = (unsigned)(c + 1);
            asm volatile("" ::: "memory");
        }
    }
    __syncthreads();
}

__device__ __forceinline__ void alpha_pass(Frame& F, bf16* O, const float* LSE, int ntok = M) {
    const size_t nitems = (size_t)ntok * 96; const size_t stride = (size_t)F.G * 512;
    for (size_t it = (size_t)F.vcu * 512 + F.tid; it < nitems; it += stride) {
        const size_t t = it / 96; const int c8 = (int)(it % 96); const int head = c8 >> 3, g = head >> 2, hg = head & 3;
        const float l0 = LSE[t * NHA + hg], l1 = LSE[t * NHA + 4 + hg], l2 = LSE[t * NHA + 8 + hg];
        const float mx = fmaxf(l0, fmaxf(l1, l2));
        const float e0 = __builtin_amdgcn_exp2f(l0 - mx), e1 = __builtin_amdgcn_exp2f(l1 - mx), e2 = __builtin_amdgcn_exp2f(l2 - mx);
        const float al = (g == 0 ? e0 : (g == 1 ? e1 : e2)) / (e0 + e1 + e2);
        GAS v4u* p = (GAS v4u*)(O + t * AW + c8 * 8); const v4u v = __builtin_nontemporal_load(p); v4u o;
#pragma unroll
        for (int i = 0; i < 4; ++i) o[i] = pk2(bf_lo(v[i]) * al, bf_hi(v[i]) * al);
        *p = o;
    }
}
__device__ __forceinline__ void twa_pass(Frame& F, const bf16* plora, const float* mu, bf16* twa, int ntok = M) {
    const size_t nitems = (size_t)ntok * 16; const size_t stride = (size_t)F.G * 512;
    for (size_t it = (size_t)F.vcu * 512 + F.tid; it < nitems; it += stride) {
        const size_t t = it >> 4; const int j0 = (int)(it & 15) * 8;
        const v4u cv = *(const GAS v4u*)(plora + t * 288 + j0); v4u pv = (v4u){0u, 0u, 0u, 0u};
        if ((t & (SEQ - 1)) != 0) pv = *(const GAS v4u*)(plora + (t - 1) * 288 + j0);
        v4u o;
#pragma unroll
        for (int i = 0; i < 4; ++i) { float a = bf_lo(cv[i]), bq = bf_hi(cv[i]); a += (bf_lo(pv[i]) - a) * mu[3072 + j0 + 2 * i]; bq += (bf_hi(pv[i]) - bq) * mu[3072 + j0 + 2 * i + 1];
            if (j0 < 64) { a = 1.0f - 2.0f * __builtin_amdgcn_rcpf(1.0f + __expf(2.0f * a)); bq = 1.0f - 2.0f * __builtin_amdgcn_rcpf(1.0f + __expf(2.0f * bq)); }
            o[i] = pk2(a, bq); }
        *(GAS v4u*)(twa + t * 128 + j0) = o;
    }
}
__device__ __forceinline__ void sgd_pass(Frame& F, const bf16* plora, const float* mu, bf16* sgd, int part = 0, int ntok = M) {
    const size_t nitems = (size_t)ntok * (part ? 16 : 32); const size_t stride = (size_t)F.G * 512;
    for (size_t it = (size_t)F.vcu * 512 + F.tid; it < nitems; it += stride) {
        const size_t t = part ? (it >> 4) : (it >> 5); const int j0 = part ? ((int)(it & 15) * 8 + (part == 2 ? 128 : 0)) : (int)(it & 31) * 8; v4u o = (v4u){0u, 0u, 0u, 0u};
        if (j0 < 160) {
            const v4u cv = *(const GAS v4u*)(plora + t * 288 + 128 + j0); v4u pv = (v4u){0u, 0u, 0u, 0u};
            if ((t & (SEQ - 1)) != 0) pv = *(const GAS v4u*)(plora + (t - 1) * 288 + 128 + j0);
#pragma unroll
            for (int i = 0; i < 4; ++i) { float a = bf_lo(cv[i]), bq = bf_hi(cv[i]); a += (bf_lo(pv[i]) - a) * mu[3200 + j0 + 2 * i]; bq += (bf_hi(pv[i]) - bq) * mu[3200 + j0 + 2 * i + 1];
                o[i] = pk2(fsigmoid(a), fsigmoid(bq)); }
        }
        *(GAS v4u*)(sgd + t * 256 + j0) = o;
    }
}

__device__ __forceinline__ void sub_barrier(gu32* cnt, unsigned n, int tid, bool same_xcd = false) {
    asm volatile("s_waitcnt vmcnt(0)" ::: "memory");
    __syncthreads();
    if (tid == 0) {
        if (!same_xcd) __builtin_amdgcn_fence(__ATOMIC_RELEASE, "agent");
        asm volatile("s_waitcnt vmcnt(0)" ::: "memory");
        (void)__hip_atomic_fetch_add(cnt, 1u, __ATOMIC_RELAXED, __HIP_MEMORY_SCOPE_AGENT);
        while (__hip_atomic_load(cnt, __ATOMIC_RELAXED, __HIP_MEMORY_SCOPE_AGENT) < n) __builtin_amdgcn_s_sleep(2);
        __builtin_amdgcn_fence(__ATOMIC_ACQUIRE, "agent");
        asm volatile("s_waitcnt vmcnt(0)" ::: "memory");
    }
    __syncthreads();
}
#define P_(T, off) ((T*)(ws + (off)))
#define xb0 ((bf16*)out)
#define W1T P_(bf16, WS_W1T)
#define W2T P_(bf16, WS_W2T)
#define WIN P_(bf16, WS_WIN)
#define WG P_(bf16, WS_WG)
#define WA P_(bf16, WS_WA)
#define WB P_(bf16, WS_WB)
#define WO P_(bf16, WS_WO)
#define G2T P_(bf16, WS_G2T)
#define W3T P_(bf16, WS_W3T)
#define W4T P_(bf16, WS_W4T)
#define L2T P_(bf16, WS_L2T)
#define SS0 P_(float, WS_SS0)
#define SS1 P_(float, WS_SS1)
#define SS2 P_(float, WS_SS2)
#define LSE P_(float, WS_LSE)
#define BON P_(float, WS_BON)
#define ACT P_(bf16, WS_ACT)
#define PR P_(bf16, WS_PR)
#define PK P_(bf16, WS_PK)
#define PV P_(bf16, WS_PV)
#define GATES P_(bf16, WS_GATES)
#define LORA P_(bf16, WS_LORA)
#define AQ P_(bf16, WS_AQ)
#define AK P_(bf16, WS_AK)
#define AV P_(bf16, WS_AV)
#define WKV P_(bf16, WS_WKV)
#define SGD P_(bf16, WS_SGD)
#define GATES_OUT ((bf16*)out)
#define XB1 P_(bf16, WS_XB1)
#define MRG P_(bf16, WS_MRG)
#define XB2 P_(bf16, WS_XB2)
#define TWA P_(bf16, WS_TWA)
struct Args { const float* in[26]; float* out; unsigned char* ws; int ph_lo, ph_hi, rep_ph, rep_n; };
__global__ void __launch_bounds__(NWAVES * 64, 2) mk_fwd(Args args) {
    extern __shared__ __attribute__((aligned(16))) unsigned char lds[];
    Frame F;
    F.lds = (LAS unsigned char*)lds;
    F.MISC = (volatile LAS unsigned*)(F.lds + MISC_OFF);
    F.tid = threadIdx.x; F.lane = F.tid & 63; F.wave = __builtin_amdgcn_readfirstlane(F.tid >> 6);
    F.G = gridDim.x; { const int bx = blockIdx.x; F.vcu = (F.G % 8 == 0) ? (bx % 8) * (F.G / 8) + bx / 8 : bx; }
    unsigned char* ws = args.ws;
    F.ctl = (gu32*)(ws + WS_CTL);
    for (int u = F.tid; u < (LDS_BYTES - LDSCTL_OFF) / 4; u += NWAVES * 64) ((LAS unsigned*)(F.lds + LDSCTL_OFF))[u] = 0u;
    __syncthreads();
    XcdBarrier bar; bar.bar = (unsigned*)(F.ctl + CW_BAR); bar.x = 0; bar.st = nullptr;
    if (N_LAUNCHES == 1) bar = xcd_barrier_post((unsigned*)(F.ctl + CW_BAR), F.MISC + 8);
    if (F.tid == 0) (void)__hip_atomic_fetch_or(F.ctl + CW_GRPM + 64 * ((int)blockIdx.x & 7), 1u << (bar.x & 31u), __ATOMIC_RELAXED, __HIP_MEMORY_SCOPE_AGENT);
#ifdef BAR_TWICE
#define GRID_BAR() do { if (N_LAUNCHES == 1) { xcd_barrier(bar); xcd_barrier(bar); } } while (0)
#else
#define GRID_BAR() do { if (N_LAUNCHES == 1) xcd_barrier(bar); } while (0)
#endif
    unsigned grp_uses = 0; bool grp_one_xcd = false;
#define GROUP_BAR() do { if (N_LAUNCHES == 1) { if (F.G == 256) sub_barrier(F.ctl + CW_GRP + 64 * ((int)blockIdx.x & 7), 32u * (++grp_uses), F.tid, grp_one_xcd); else xcd_barrier(bar); } } while (0)
#define LAG_GUARD() do { if (N_LAUNCHES == 1 && F.G == 256) { const gu32* p_ = F.ctl + CW_GRP + 64 * (F.tid & 7); if ((F.tid & 63) < 8) while (__hip_atomic_load(p_, __ATOMIC_RELAXED, __HIP_MEMORY_SCOPE_AGENT) < 32u * grp_uses) __builtin_amdgcn_s_sleep(1); asm volatile("" ::: "memory"); } } while (0)
    const int lo = args.ph_lo, hi = args.ph_hi;
#ifndef PHMASK
#define PHMASK 0x7ff
#endif
#define IN(k) (((PHMASK >> (k)) & 1) && lo <= (k) && (k) < hi)
#define BOTH(k) (IN(k) && IN((k) + 1))
#define REP(k) for (int rep_ = 0, nrep_ = (args.rep_ph == (k) ? args.rep_n : 1); rep_ < nrep_; ++rep_)
    const float* x = args.in[0];
    float* out = args.out;
    const int cid = (int)blockIdx.x;

    if (IN(0)) { REP(0) { P0Args pa; for (int i = 0; i < 26; ++i) pa.in[i] = args.in[i]; pa.ws = ws; pa.out = out; p0_prologue(F, pa, 0, F.vcu * NWAVES + F.wave, F.G * NWAVES);
        if (F.G == 256) p0_prologue(F, pa, 1, F.vcu * NWAVES + F.wave, F.G * NWAVES); }
        if (BOTH(0)) GRID_BAR(); }
    if (N_LAUNCHES == 1 && IN(0)) { const unsigned m_ = (unsigned)__builtin_amdgcn_readfirstlane((int)__hip_atomic_load(F.ctl + CW_GRPM + 64 * ((int)blockIdx.x & 7), __ATOMIC_RELAXED, __HIP_MEMORY_SCOPE_AGENT)); grp_one_xcd = __builtin_popcount(m_) == 1; }
#ifdef SHADOW_P1
#ifdef SHADOW_ZERO
    if (IN(1)) { pg8::Gemm g{XB2, W3T, M, 2 * FF, D};
#else
    if (IN(1)) { pg8::Gemm g{xb0, W1T, M, 2 * FF, D};
#endif
        pg8::SameTileOrder S; S.init(M, 2 * FF, F.G, cid); pg8::EpiSwiglu E{ACT, SS0};
        pg8::gemm_phase<pg8::EpiSwiglu, pg8::SameTileOrder, true, true>(F.lds + RING_OFF, g, S, E); GRID_BAR(); }
#endif
    if (IN(1)) { REP(1) { pg8::Gemm g{xb0, W1T, M, 2 * FF, D, 3}; pg8::StaticOrder S; S.init(M, 2 * FF, F.G, cid); pg8::EpiSwiglu E{ACT, SS0};
        pg8::gemm_phase<pg8::EpiSwiglu, pg8::StaticOrder, true, true>(F.lds + RING_OFF, g, S, E); } if (BOTH(1)) GROUP_BAR(); }
    if (IN(2)) { REP(2) { pg8::Gemm g{ACT, W2T, M, D, FF, 3}; pg8::StaticOrder S; S.init(M, D, F.G, cid); pg8::EpiResid<true, false, true> E{xb0, nullptr, XB1, SS1, 0.5f};
        pg8::gemm_phase<pg8::EpiResid<true, false, true>, pg8::StaticOrder, true, true>(F.lds + RING_OFF, g, S, E); } if (BOTH(2)) GROUP_BAR(); }
    if (IN(3)) { pg8::EpiMix E{ws, SS1, args.in[18], args.in[19]};
        if (F.G == 256) {
            pg8::Gemm g{XB1, WIN, M, 23 * 256, D, 3}; pg8::Guarded<pg8::SkipOrder> S; S.init2(M, 22 * 256, F.G, cid, 13); S.arm((const unsigned*)(F.ctl + CW_GRP), 64, 32u * grp_uses, N_LAUNCHES == 1);
            REP(3) pg8::gemm_phase<pg8::EpiMix, pg8::Guarded<pg8::SkipOrder>, true, true>(F.lds + RING_OFF, g, S, E);
        } else {
            pg8::Gemm g{XB1, WIN, M, 23 * 256, D, 3}; pg8::StaticOrder S; S.init(M, 23 * 256, F.G, cid);
            if (cid >= F.G / 2) { P0Args pa; for (int i = 0; i < 26; ++i) pa.in[i] = args.in[i]; pa.ws = ws; pa.out = out; p0_prologue(F, pa, 1, (cid - F.G / 2) * NWAVES + F.wave, (F.G - F.G / 2) * NWAVES);
                __syncthreads(); }
            pg8::gemm_phase<pg8::EpiMix, pg8::StaticOrder, true, true>(F.lds + RING_OFF, g, S, E);
        }
        if (BOTH(3)) GROUP_BAR(); }
    if (IN(4)) { if (args.rep_ph == 4) attn_phase(F, cid, F.G, NB_ * NHA * 32, AQ, AK, AV, AQ, LSE, false);
        if (F.G == 256) {
            const int g_ = (int)blockIdx.x & 7, j_ = (int)blockIdx.x >> 3;
            attn_phase(F, g_ * (NHA * 32) + j_, 32, (g_ + 1) * (NHA * 32), AQ, AK, AV, AQ, LSE, true);
            Frame F2 = F; F2.vcu = j_; F2.G = 32; twa_pass(F2, LORA + (size_t)g_ * SEQ * 288, args.in[7], TWA + (size_t)g_ * SEQ * 128, SEQ);
        } else { attn_phase(F, cid, F.G, NB_ * NHA * 32, AQ, AK, AV, AQ, LSE, true); twa_pass(F, LORA, args.in[7], TWA); }
        if (F.G == 256 && IN(5)) { const int bx = (int)blockIdx.x; if (!((bx >> 3) & 1)) {
            ScanArgs sa{PR, PK, PV, LORA, L2T, args.in[7], args.in[8], args.in[10], args.in[13], args.in[14], args.in[15], WKV, BON, TWA};
            scan2_stage<true>(F, sa, (bx & 7) * 16 + (bx >> 4)); } }
        if (BOTH(4)) GROUP_BAR(); }
    if (IN(5)) {
        ScanArgs sa{PR, PK, PV, LORA, L2T, args.in[7], args.in[8], args.in[10], args.in[13], args.in[14], args.in[15], WKV, BON, TWA};
        if (F.G == 256) {
            const int bx = (int)blockIdx.x; const int role = (bx >> 3) & 1, sub = (bx & 7) | ((bx >> 4) << 3);
            if (!role) scan2_unit<true>(F, sa, (bx & 7) * 16 + (bx >> 4), IN(4), (N_LAUNCHES == 1) ? (const gu32*)(F.ctl + CW_GRP) : (const gu32*)nullptr, 32u * grp_uses);
            else {
                Frame F2 = F; F2.vcu = sub >> 3; F2.G = 16; const int gb = sub & 7;
                alpha_pass(F2, AQ + (size_t)gb * SEQ * AW, LSE + (size_t)gb * SEQ * NHA, SEQ); LAG_GUARD();     sgd_pass(F2, LORA + (size_t)gb * SEQ * 288, args.in[7], SGD + (size_t)gb * SEQ * 256, 1, SEQ);
                __syncthreads();
                { pg8::Gemm g13{XB1, WIN, M, 23 * 256, D, 3}; pg8::ColsOrder S13; S13.init2(M, 256, 128, sub, 13); pg8::EpiMix E13{ws, SS1, args.in[18], args.in[19]};
                  pg8::gemm_phase<pg8::EpiMix, pg8::ColsOrder, true, true>(F.lds + RING_OFF, g13, S13, E13); }
                pg8::Gemm g{XB1, WG, M, 2 * D, D, 3}; pg8::StaticOrder S; S.init(M, 2 * D, 128, sub); pg8::EpiGates E{GATES_OUT, SS1, args.in[6]};
                pg8::gemm_phase<pg8::EpiGates, pg8::StaticOrder, true, true>(F.lds + RING_OFF, g, S, E);
                sub_barrier(F.ctl + CW_SUB2 + 64 * gb, 16u, F.tid, grp_one_xcd);
                sgd_pass(F2, LORA + (size_t)gb * SEQ * 288, args.in[7], SGD + (size_t)gb * SEQ * 256, 2, SEQ);
            }
        } else {
            REP(5) for (int u = cid; u < NB_ * 32; u += F.G) scan2_unit<false>(F, sa, u);
            alpha_pass(F, AQ, LSE); REP(12) sgd_pass(F, LORA, args.in[7], SGD);
        }
        if (BOTH(5)) GROUP_BAR(); }
    if (IN(6)) {
        if (F.G != 256) { pg8::Gemm g{XB1, WG, M, 2 * D, D, 3}; pg8::StaticOrder S; S.init(M, 2 * D, F.G, cid); pg8::EpiGates E{GATES_OUT, SS1, args.in[6]};
          REP(6) pg8::gemm_phase<pg8::EpiGates, pg8::StaticOrder, true, true>(F.lds + RING_OFF, g, S, E); }
        const bool projb_first = (F.G == 256) && (((int)blockIdx.x & 1) != 0);
        if (projb_first && IN(7)) { pg8::Gemm g{AQ, WB, M, D, AW, 2}; pg8::StaticOrder S; S.init(M, D, F.G, cid); pg8::EpiProj<false, 1> E{MRG, GATES_OUT};
          pg8::gemm_phase<pg8::EpiProj<false, 1>, pg8::StaticOrder, true, true>(F.lds + RING_OFF, g, S, E); }
        { LAS float* cl = (LAS float*)(F.lds + RING_OFF + pg8::STAGE_BYTES);
          for (int i = F.tid; i < 1024; i += NWAVES * 64) { cl[i] = args.in[16][i]; cl[1024 + i] = args.in[17][i]; cl[2048 + i] = args.in[7][2048 + i]; }
          __syncthreads(); }
        { pg8::Gemm g{SGD, G2T, M, D, 256, 2}; pg8::StaticOrder S; S.init(M, D, F.G, cid); pg8::EpiGn E{WKV, PV, BON, (const LAS float*)(F.lds + RING_OFF + pg8::STAGE_BYTES)};
          pg8::gemm_phase<pg8::EpiGn, pg8::StaticOrder, true, true>(F.lds + RING_OFF, g, S, E); }
        if (BOTH(6)) GROUP_BAR(); }
    if (IN(7)) {
        const bool projb_first = (F.G == 256) && (((int)blockIdx.x & 1) != 0) && IN(6);
        if (projb_first) {
            pg8::Gemm g{WKV, WA, M, D, D, 2}; pg8::StaticOrder S; S.init(M, D, F.G, cid); pg8::EpiProj<true, 0> E{MRG, GATES_OUT};
            pg8::gemm_phase<pg8::EpiProj<true, 0>, pg8::StaticOrder, true, true>(F.lds + RING_OFF, g, S, E);
        } else {
            { pg8::Gemm g{WKV, WA, M, D, D, 2}; pg8::StaticOrder S; S.init(M, D, F.G, cid); pg8::EpiProj<false, 0> E{MRG, GATES_OUT};
              REP(7) pg8::gemm_phase<pg8::EpiProj<false, 0>, pg8::StaticOrder, true, true>(F.lds + RING_OFF, g, S, E); }
            { pg8::Gemm g{AQ, WB, M, D, AW, 2}; pg8::StaticOrder S; S.init(M, D, F.G, cid); pg8::EpiProj<true, 1> E{MRG, GATES_OUT};
              pg8::gemm_phase<pg8::EpiProj<true, 1>, pg8::StaticOrder, true, true>(F.lds + RING_OFF, g, S, E); }
        }
        if (BOTH(7)) GROUP_BAR(); }
    if (IN(8)) { pg8::Gemm g{MRG, WO, M, D, D, 3}; pg8::Guarded<pg8::StaticOrder> S; S.init(M, D, F.G, cid); S.arm((const unsigned*)(F.ctl + CW_GRP), 64, 32u * grp_uses, N_LAUNCHES == 1 && F.G == 256); pg8::EpiResid<true, false, true> E{XB1, nullptr, XB2, SS2, 1.0f};
        pg8::gemm_phase<pg8::EpiResid<true, false, true>, pg8::Guarded<pg8::StaticOrder>, true, true>(F.lds + RING_OFF, g, S, E); if (BOTH(8)) GROUP_BAR(); }
    if (IN(9)) { pg8::Gemm g{XB2, W3T, M, 2 * FF, D, 3}; pg8::Guarded<pg8::StaticOrder> S; S.init(M, 2 * FF, F.G, cid); S.arm((const unsigned*)(F.ctl + CW_GRP), 64, 32u * grp_uses, N_LAUNCHES == 1 && F.G == 256); pg8::EpiSwiglu E{ACT, SS2};
        REP(9) pg8::gemm_phase<pg8::EpiSwiglu, pg8::Guarded<pg8::StaticOrder>, true, true>(F.lds + RING_OFF, g, S, E); if (BOTH(9)) GROUP_BAR(); }
    if (IN(10)) { pg8::Gemm g{ACT, W4T, M, D, FF, 3}; pg8::StaticOrder S; S.init(M, D, F.G, cid); pg8::EpiResid<true, true, false> E{XB2, out, nullptr, nullptr, 0.5f};
        REP(10) pg8::gemm_phase<pg8::EpiResid<true, true, false>, pg8::StaticOrder, true, true>(F.lds + RING_OFF, g, S, E); }

#undef IN
#undef BOTH
}

extern "C" void kernel_launch(void* const* d_in, const int* in_sizes, int n_in, void* d_out, int out_size, void* d_ws, size_t ws_size, hipStream_t stream) {
    static int grid = 0;
    if (grid == 0) {
        if (n_in != 26 || in_sizes[0] != M * D || out_size != M * D || ws_size < WS_END) { fprintf(stderr, "kernel_launch: unexpected shapes: n_in %d in0 %d out %d ws %zu (need %zu)\n", n_in, n_in > 0 ? in_sizes[0] : -1, out_size, ws_size, (size_t)WS_END); grid = -1; return; }
        int dev = 0, cus = 0, per_cu = 0;
        if (hipGetDevice(&dev) != hipSuccess || hipDeviceGetAttribute(&cus, hipDeviceAttributeMultiprocessorCount, dev) != hipSuccess) { grid = -1; return; }
        if (hipFuncSetAttribute((const void*)mk_fwd, hipFuncAttributeMaxDynamicSharedMemorySize, LDS_BYTES) != hipSuccess) { fprintf(stderr, "kernel_launch: hipFuncSetAttribute failed\n"); grid = -1; return; }
        if (hipOccupancyMaxActiveBlocksPerMultiprocessor(&per_cu, (const void*)mk_fwd, NWAVES * 64, LDS_BYTES) != hipSuccess || per_cu < 1) fprintf(stderr, "kernel_launch: occupancy query reports %d per CU\n", per_cu);
        (void)hipGetLastError();
        grid = cus;
    }
    if (grid < 0) return;
    if (hipMemsetAsync((char*)d_ws + WS_CTL, 0, CTL_ZERO_BYTES, stream) != hipSuccess) return;
#ifdef SHADOW_ZERO
    (void)hipMemsetAsync((char*)d_ws + WS_XB2, 0, (size_t)M * D * 2, stream); (void)hipMemsetAsync((char*)d_ws + WS_W3T, 0, (size_t)2 * FF * D * 2, stream);
#endif
    Args a{};
    for (int i = 0; i < 26; ++i) a.in[i] = (const float*)d_in[i];
    a.out = (float*)d_out; a.ws = (unsigned char*)d_ws;
#ifndef REP_PH
#define REP_PH -1
#endif
#ifndef REP_N
#define REP_N 1
#endif
    a.rep_ph = REP_PH; a.rep_n = REP_N;
    if (N_LAUNCHES == 1) { a.ph_lo = 0; a.ph_hi = NPH; hipLaunchKernelGGL(mk_fwd, dim3(grid), dim3(NWAVES * 64), LDS_BYTES, stream, a); }
    else for (int li = 0; li < NPH; ++li) { a.ph_lo = li; a.ph_hi = li + 1; hipLaunchKernelGGL(mk_fwd, dim3(grid), dim3(NWAVES * 64), LDS_BYTES, stream, a); }
}
```
